# Optimizing an MI355X kernel written in HIP

```python
import jax, jax.numpy as jnp
from jax import lax
import numpy as np

D_MODEL = 1024
BATCH = 2
SEQ = 16384
DEPTH = 2

GRID_W = 64
CTX_LEN = 256
D_MIX = D_MODEL
RWKV_HEAD = 64
RWKV_WIDTH = D_MIX // 2
RWKV_HEADS = RWKV_WIDTH // RWKV_HEAD
DECAY_LORA = 64
ICLR_LORA = 64
GATE_LORA = 128
RWKV_COLS = 3 * RWKV_WIDTH + DECAY_LORA + ICLR_LORA + GATE_LORA
RWKV_SPLITS = (RWKV_WIDTH, 2 * RWKV_WIDTH, 3 * RWKV_WIDTH, 3 * RWKV_WIDTH + DECAY_LORA, 3 * RWKV_WIDTH + DECAY_LORA + ICLR_LORA)
SHIFT_TAPS = 3
POOL_WIDTH = D_MIX // 4
POOL_WINDOWS = (2, 4, 8, 16)
POOL_GROUPS = len(POOL_WINDOWS)
POOL_GC = POOL_WIDTH // POOL_GROUPS
FOURIER_WIDTH = D_MIX - RWKV_WIDTH - POOL_WIDTH
FOURIER_HEADS = 4
FOURIER_HC = FOURIER_WIDTH // FOURIER_HEADS
IN_COLS = RWKV_COLS + POOL_WIDTH + FOURIER_WIDTH
MIX_SPLITS = (RWKV_COLS, RWKV_COLS + POOL_WIDTH)
N_EXPERTS = 16
EXPERT_FF = D_MODEL
CAPACITY_FACTOR = 2
N_MOD = 6
RMS_EPS = 1e-6
LNX_EPS = 64e-5
F32 = jnp.float32

kernel_name = "hybrid_rwkv7_pool_fourier_ec_moe_dit"


def heads(t):
    return t.reshape(t.shape[0], t.shape[1], RWKV_HEADS, RWKV_HEAD)


def rmsnorm(x, g):
    xf = x.astype(F32)
    y = xf * lax.rsqrt(jnp.mean(xf * xf, axis=-1, keepdims=True) + RMS_EPS)
    return (y * g.astype(F32)).astype(x.dtype)


def adaln(cond, ada_w, ada_b):
    return jnp.split(jax.nn.silu(cond) @ ada_w + ada_b, N_MOD, axis=-1)


def modulate(x, shift, scale):
    return x * (1 + scale) + shift


def centred_shift(u, shift_w):
    up = jnp.pad(u, ((0, 0), (1, 1), (0, 0)))
    return up[:, :-2] * shift_w[0] + up[:, 1:-1] * shift_w[1] + up[:, 2:] * shift_w[2]


def rwkv_features(u, shift_w, k_k):
    u = centred_shift(u, shift_w)
    r, k, v, xw, xa, xg = jnp.split(u, RWKV_SPLITS, axis=-1)
    kk = heads(k * k_k).astype(F32)
    kk = kk * lax.rsqrt(jnp.sum(kk * kk, axis=-1, keepdims=True) + 1e-12)
    return r, k, v, xw, xa, xg, kk


def rwkv_direction(k, xw, xa, kk, w0, w_up, a0, a_up, k_a):
    w_log = -jax.nn.softplus(-(w0 + jnp.tanh(xw) @ w_up).astype(F32)) - 0.5
    decay = jnp.exp(-jnp.exp(w_log))
    a_lr = jax.nn.sigmoid(a0 + xa @ a_up)
    k_dir = k * (1 + (a_lr - 1) * k_a)
    return heads(decay), heads(k_dir), -kk, kk * heads(a_lr).astype(F32)


def delta_scan(r, w, k, v, a, b, s0, reverse, with_y):
    seqs = (w, k, v, a, b) + ((r,) if with_y else ())
    xs = tuple(jnp.moveaxis(t.astype(F32), 1, 0) for t in seqs)

    def step(S, inp):
        w_t, k_t, v_t, a_t, b_t = inp[:5]
        sa = jnp.einsum("bhvk,bhk->bhv", S, a_t)
        S = S * w_t[:, :, None, :] + sa[..., None] * b_t[:, :, None, :] + v_t[..., None] * k_t[:, :, None, :]
        y = jnp.einsum("bhvk,bhk->bhv", S, inp[5]) if with_y else None
        return S, y

    S, ys = lax.scan(step, s0, xs, reverse=reverse)
    return (jnp.moveaxis(ys, 0, 1) if with_y else None), S


def rwkv_readout(y, bonus, v, xg, gate_up, lnx_g, lnx_b):
    B, T = y.shape[0], y.shape[1]
    mu = jnp.mean(y, axis=-1, keepdims=True)
    var = jnp.mean(jnp.square(y - mu), axis=-1, keepdims=True)
    yn = ((y - mu) * lax.rsqrt(var + LNX_EPS)).reshape(B, T, RWKV_WIDTH) * lnx_g + lnx_b
    yn = yn + (bonus[..., None] * heads(v).astype(F32)).reshape(B, T, RWKV_WIDTH)
    return (yn * (jax.nn.sigmoid(xg) @ gate_up)).astype(v.dtype)


def rwkv_mixer(u_lat, u_ctx, ctx_out, shift_w, decay_w0, decay_up, iclr_a0, iclr_up, gate_up, k_k, k_a, r_k, lnx_g, lnx_b):
    r_l, k_l, v_l, xw_l, xa_l, xg_l, kk_l = rwkv_features(u_lat, shift_w, k_k)
    r_c, k_c, v_c, xw_c, xa_c, xg_c, kk_c = rwkv_features(u_ctx, shift_w, k_k)
    s_zero = jnp.zeros((u_ctx.shape[0], RWKV_HEADS, RWKV_HEAD, RWKV_HEAD), F32)
    y_lat, bonus_lat, y_ctx, bonus_ctx = [], [], [], []
    for d in range(2):
        rev = d == 1
        w_c, kd_c, a_c, b_c = rwkv_direction(k_c, xw_c, xa_c, kk_c, decay_w0[d], decay_up[d], iclr_a0[d], iclr_up[d], k_a)
        yc, s_ctx = delta_scan(heads(r_c), w_c, kd_c, heads(v_c), a_c, b_c, s_zero, rev, ctx_out)
        w_l, kd_l, a_l, b_l = rwkv_direction(k_l, xw_l, xa_l, kk_l, decay_w0[d], decay_up[d], iclr_a0[d], iclr_up[d], k_a)
        yl, _ = delta_scan(heads(r_l), w_l, kd_l, heads(v_l), a_l, b_l, s_ctx, rev, True)
        y_lat.append(yl)
        bonus_lat.append(jnp.sum(heads(r_l) * kd_l * r_k, axis=-1))
        if ctx_out:
            y_ctx.append(yc)
            bonus_ctx.append(jnp.sum(heads(r_c) * kd_c * r_k, axis=-1))
    out_lat = rwkv_readout(y_lat[0] + y_lat[1], bonus_lat[0] + bonus_lat[1], v_l, xg_l, gate_up, lnx_g, lnx_b)
    out_ctx = rwkv_readout(y_ctx[0] + y_ctx[1], bonus_ctx[0] + bonus_ctx[1], v_c, xg_c, gate_up, lnx_g, lnx_b) if ctx_out else None
    return out_lat, out_ctx


def window_bounds(n, win):
    pos = jnp.arange(n)
    return jnp.maximum(pos - win // 2, 0), jnp.minimum(pos + win // 2, n)


def pool2d_minus_self(u, rows):
    B, T, C = u.shape
    grid = u.reshape(B, rows, GRID_W, C).astype(F32)
    sat = jnp.pad(jnp.cumsum(jnp.cumsum(grid, axis=1), axis=2), ((0, 0), (1, 0), (1, 0), (0, 0)))
    means = []
    for gi, win in enumerate(POOL_WINDOWS):
        s = sat[..., gi * POOL_GC:(gi + 1) * POOL_GC]
        r_lo, r_hi = window_bounds(rows, win)
        c_lo, c_hi = window_bounds(GRID_W, win)
        s_hi, s_lo = s[:, r_hi], s[:, r_lo]
        box = s_hi[:, :, c_hi] - s_lo[:, :, c_hi] - s_hi[:, :, c_lo] + s_lo[:, :, c_lo]
        count = ((r_hi - r_lo)[:, None] * (c_hi - c_lo)[None, :]).astype(F32)
        means.append(box / count[None, :, :, None])
    pooled = jnp.concatenate(means, axis=-1).reshape(B, T, C)
    return (pooled - u.astype(F32)).astype(u.dtype)


def pool1d_minus_self(u):
    B, T, C = u.shape
    cs = jnp.pad(jnp.cumsum(u.astype(F32), axis=1), ((0, 0), (1, 0), (0, 0)))
    means = []
    for gi, win in enumerate(POOL_WINDOWS):
        s = cs[..., gi * POOL_GC:(gi + 1) * POOL_GC]
        lo, hi = window_bounds(T, win)
        means.append((s[:, hi] - s[:, lo]) / (hi - lo).astype(F32)[None, :, None])
    return (jnp.concatenate(means, axis=-1) - u.astype(F32)).astype(u.dtype)


def pool_readout(p, pool_w, pool_scale):
    B, T = p.shape[0], p.shape[1]
    ph = p.reshape(B, T, POOL_GROUPS, POOL_GC)
    return jnp.einsum("btgc,gcd->btgd", ph, pool_w).reshape(B, T, POOL_WIDTH) * pool_scale


def fourier_mixer(u, fourier_w):
    B, T = u.shape[0], u.shape[1]
    uh = u.reshape(B, T, FOURIER_HEADS, FOURIER_HC).astype(F32)
    f = jnp.real(jnp.fft.fft2(uh, axes=(1, 3), norm="ortho")).astype(u.dtype)
    return jnp.einsum("bthc,hcd->bthd", f, fourier_w).reshape(B, T, FOURIER_WIDTH)


def token_mixing(xn_lat, xn_ctx, rows, ctx_out, w_in, shift_w, decay_w0, decay_up, iclr_a0, iclr_up, gate_up,
                 k_k, k_a, r_k, lnx_g, lnx_b, pool_w, pool_scale, fourier_w, w_out):
    p_lat = xn_lat @ w_in
    p_ctx = xn_ctx @ (w_in if ctx_out else w_in[:, :RWKV_COLS])
    u_rw_l, u_pool_l, u_four_l = jnp.split(p_lat, MIX_SPLITS, axis=-1)
    rw_l, rw_c = rwkv_mixer(u_rw_l, p_ctx[..., :RWKV_COLS], ctx_out, shift_w, decay_w0, decay_up, iclr_a0, iclr_up,
                            gate_up, k_k, k_a, r_k, lnx_g, lnx_b)
    out_lat = jnp.concatenate([rw_l, pool_readout(pool2d_minus_self(u_pool_l, rows), pool_w, pool_scale),
                               fourier_mixer(u_four_l, fourier_w)], axis=-1) @ w_out
    if not ctx_out:
        return out_lat, None
    _, u_pool_c, u_four_c = jnp.split(p_ctx, MIX_SPLITS, axis=-1)
    out_ctx = jnp.concatenate([rw_c, pool_readout(pool1d_minus_self(u_pool_c), pool_w, pool_scale),
                               fourier_mixer(u_four_c, fourier_w)], axis=-1) @ w_out
    return out_lat, out_ctx


def expert_choice_ffn(h, router_w, w_gate, w_up, w_down):
    B, T, D = h.shape
    cap = CAPACITY_FACTOR * T // N_EXPERTS
    affinity = jax.nn.softmax((h @ router_w).astype(F32), axis=-1)
    gates, idx = lax.top_k(jnp.swapaxes(affinity, 1, 2), cap)
    xe = jax.vmap(lambda hb, ib: hb[ib])(h, idx)
    hid = jax.nn.silu(jnp.einsum("becd,edf->becf", xe, w_gate)) * jnp.einsum("becd,edf->becf", xe, w_up)
    ye = jnp.einsum("becf,efd->becd", hid, w_down) * gates[..., None].astype(h.dtype)
    return jax.vmap(lambda yb, ib: jnp.zeros((T, D), yb.dtype).at[ib.reshape(-1)].add(yb.reshape(-1, D)))(ye, idx)


def setup_inputs(seed: int = 0) -> dict:
    key = jax.random.key(seed)
    ks = iter(jax.random.split(key, 32))
    L, D, W = DEPTH, D_MODEL, RWKV_WIDTH

    def nrm(shape, scale):
        return jax.random.normal(next(ks), shape, F32) * scale

    shift_base = jnp.array([0.25, 0.5, 0.25], F32)[None, :, None]
    return {
        "x": nrm((BATCH, SEQ, D), 1.0),
        "c": nrm((BATCH, D), 1.0),
        "ctx": nrm((BATCH, CTX_LEN, D), 1.0),
        "c_ctx": nrm((D,), 1.0),
        "ada_w": nrm((L, D, N_MOD * D), 0.5 * D ** -0.5),
        "ada_b": nrm((L, N_MOD * D), 0.01),
        "norm_mix_g": 1.0 + nrm((L, D), 0.02),
        "norm_ffn_g": 1.0 + nrm((L, D), 0.02),
        "w_in": nrm((L, D, IN_COLS), D ** -0.5),
        "shift_w": shift_base + nrm((L, SHIFT_TAPS, RWKV_COLS), 0.05),
        "decay_w0": jax.random.uniform(next(ks), (L, 2, W), F32, -6.0, 0.5),
        "decay_up": nrm((L, 2, DECAY_LORA, W), 0.1),
        "iclr_a0": nrm((L, 2, W), 0.1),
        "iclr_up": nrm((L, 2, ICLR_LORA, W), 0.1),
        "gate_up": nrm((L, GATE_LORA, W), GATE_LORA ** -0.5),
        "k_k": 0.85 + nrm((L, W), 0.05),
        "k_a": 1.0 + nrm((L, W), 0.05),
        "r_k": nrm((L, RWKV_HEADS, RWKV_HEAD), 0.1),
        "lnx_g": 1.0 + nrm((L, W), 0.02),
        "lnx_b": nrm((L, W), 0.01),
        "pool_w": nrm((L, POOL_GROUPS, POOL_GC, POOL_GC), POOL_GC ** -0.5),
        "pool_scale": 1.0 + nrm((L, POOL_WIDTH), 0.1),
        "fourier_w": nrm((L, FOURIER_HEADS, FOURIER_HC, FOURIER_HC), FOURIER_HC ** -0.5),
        "w_out": nrm((L, D_MIX, D), D_MIX ** -0.5),
        "router_w": nrm((L, D, N_EXPERTS), D ** -0.5),
        "exp_w_gate": nrm((L, N_EXPERTS, D, EXPERT_FF), D ** -0.5),
        "exp_w_up": nrm((L, N_EXPERTS, D, EXPERT_FF), D ** -0.5),
        "exp_w_down": nrm((L, N_EXPERTS, EXPERT_FF, D), EXPERT_FF ** -0.5),
        "final_norm_g": 1.0 + nrm((D,), 0.02),
    }


def reference(x, c, ctx, c_ctx, ada_w, ada_b, norm_mix_g, norm_ffn_g, w_in, shift_w, decay_w0, decay_up, iclr_a0,
              iclr_up, gate_up, k_k, k_a, r_k, lnx_g, lnx_b, pool_w, pool_scale, fourier_w, w_out, router_w,
              exp_w_gate, exp_w_up, exp_w_down, final_norm_g):
    rows = x.shape[1] // GRID_W
    h_lat, h_ctx = x, ctx
    for l in range(DEPTH):
        ctx_out = l < DEPTH - 1
        sh1_l, sc1_l, g1_l, sh2_l, sc2_l, g2_l = [m[:, None, :] for m in adaln(c, ada_w[l], ada_b[l])]
        sh1_c, sc1_c, g1_c, sh2_c, sc2_c, g2_c = adaln(c_ctx, ada_w[l], ada_b[l])
        mix_lat, mix_ctx = token_mixing(
            modulate(rmsnorm(h_lat, norm_mix_g[l]), sh1_l, sc1_l),
            modulate(rmsnorm(h_ctx, norm_mix_g[l]), sh1_c, sc1_c),
            rows, ctx_out, w_in[l], shift_w[l], decay_w0[l], decay_up[l], iclr_a0[l], iclr_up[l], gate_up[l],
            k_k[l], k_a[l], r_k[l], lnx_g[l], lnx_b[l], pool_w[l], pool_scale[l], fourier_w[l], w_out[l])
        h_lat = h_lat + g1_l * mix_lat
        h_lat = h_lat + g2_l * expert_choice_ffn(modulate(rmsnorm(h_lat, norm_ffn_g[l]), sh2_l, sc2_l),
                                                 router_w[l], exp_w_gate[l], exp_w_up[l], exp_w_down[l])
        if ctx_out:
            h_ctx = h_ctx + g1_c * mix_ctx
            h_ctx = h_ctx + g2_c * expert_choice_ffn(modulate(rmsnorm(h_ctx, norm_ffn_g[l]), sh2_c, sc2_c),
                                                     router_w[l], exp_w_gate[l], exp_w_up[l], exp_w_down[l])
    return rmsnorm(h_lat, final_norm_g)
```

```cpp
#include <hip/hip_runtime.h>
#include <cstdio>
#include <cstdint>
#include <cmath>

#define LAS __attribute__((address_space(3)))
typedef unsigned short bf16_t;
typedef short bf16x8 __attribute__((ext_vector_type(8)));
typedef float f32x4 __attribute__((ext_vector_type(4)));
typedef unsigned u32x4 __attribute__((ext_vector_type(4)));
typedef unsigned u32x2 __attribute__((ext_vector_type(2)));

constexpr int NB = 2, T = 16384, TC = 256, D = 1024;
constexpr int LAT = NB * T, MT = LAT + NB * TC;
constexpr int INC = 2304, MIXK = 1280;
constexpr int CAP = 2048, CAPC = 32;
constexpr int XE_ROWS = 65536 + 32 * 256;
constexpr int NT = 512;

constexpr size_t OFF_CTL   = 0;
constexpr size_t OFF_MODS  = 16384;
constexpr size_t OFF_WINT  = OFF_MODS + 147456;
constexpr size_t OFF_WOT   = OFF_WINT + 9437184;
constexpr size_t OFF_DUPT  = OFF_WOT + 5242880;
constexpr size_t OFF_IUPT  = OFF_DUPT + 262144;
constexpr size_t OFF_GUPT  = OFF_IUPT + 262144;
constexpr size_t OFF_WCS   = OFF_GUPT + 262144;
constexpr size_t OFF_D1    = OFF_WCS + 262144;
constexpr size_t OFF_DCTX  = OFF_D1 + 65536;
constexpr size_t OFF_E2    = OFF_DCTX + 262144;
constexpr size_t OFF_HCTX  = OFF_E2 + 16777216;
constexpr size_t OFF_AFF   = OFF_HCTX + 2097152;
constexpr size_t OFF_AFFC  = OFF_AFF + 2097152;
constexpr size_t OFF_IDX   = OFF_AFFC + 32768;
constexpr size_t OFF_GATE  = OFF_IDX + 294912;
constexpr size_t OFF_INV   = OFF_GATE + 294912;
constexpr size_t OFF_BONUS = OFF_INV + 2129920;
constexpr size_t OFF_XN    = OFF_BONUS + 2129920;
constexpr size_t OFF_BIG   = OFF_XN + 68157440;
constexpr size_t OFF_P     = OFF_BIG;
constexpr size_t OFF_MIX   = OFF_P + 153354240;
constexpr size_t OFF_SCAN  = OFF_MIX + 85196800;
constexpr size_t OFF_Y1    = OFF_SCAN + 136314880;
constexpr size_t END_MIXV  = OFF_Y1 + 33554432;
constexpr size_t OFF_WGU   = OFF_BIG;
constexpr size_t OFF_WD    = OFF_WGU + 67108864;
constexpr size_t OFF_XE    = OFF_WD + 33554432;
constexpr size_t OFF_HID   = OFF_XE + 150994944;
constexpr size_t END_MOEV  = OFF_HID + 150994944;
constexpr size_t WS_NEED   = END_MIXV > END_MOEV ? END_MIXV : END_MOEV;

constexpr int SLOT = 9216;
constexpr int LDS_LW   = 14 * SLOT;
constexpr int LDS_SEG  = LDS_LW + 64 * 68 * 4;
constexpr int LDS_GL   = LDS_SEG + 8 * 64 * 4;
constexpr int LDS_BON  = LDS_GL + 256;
constexpr int LDS_MISC = LDS_BON + 256;
constexpr int LDS_BYTES = LDS_MISC + 256;

#ifndef PHMASK
#define PHMASK 0xffffffffu
#endif
#define EN(n) (((PHMASK) >> (n)) & 1u)
struct Params { const float* in[29]; float* out; unsigned char* ws; };


__device__ __forceinline__ int opaque_tid() { int t = threadIdx.x; asm volatile("" : "+v"(t)); return t; }
__device__ __forceinline__ Params launder(const Params& P0) {
    Params Q;
#pragma unroll
    for (int i = 0; i < 29; ++i) { const float* p = P0.in[i]; asm volatile("" : "+s"(p)); Q.in[i] = p; }
    { float* o = P0.out; asm volatile("" : "+s"(o)); Q.out = o; }
    { unsigned char* w = P0.ws; asm volatile("" : "+s"(w)); Q.ws = w; }
    return Q;
}
__device__ __forceinline__ float bf2f(unsigned b) { return __uint_as_float(b << 16); }
typedef __bf16 bf16v2_t __attribute__((ext_vector_type(2)));
typedef float f32v2_t __attribute__((ext_vector_type(2)));
__device__ __forceinline__ unsigned cvt_pk(float lo, float hi) { const f32v2_t v = {lo, hi}; const bf16v2_t b = __builtin_convertvector(v, bf16v2_t); return __builtin_bit_cast(unsigned, b); }
__device__ __forceinline__ bf16_t f2bf(float f) { return (bf16_t)(cvt_pk(f, 0.f) & 0xffffu); }
__device__ __forceinline__ float wave_sum(float v) {
#pragma unroll
    for (int o = 1; o < 64; o <<= 1) v += __shfl_xor(v, o);
    return v;
}
__device__ __forceinline__ float sigmoidf_(float x) { return 1.0f / (1.0f + __expf(-x)); }

#define XB_TMO      128
#define XB_XCNT(j)  (256  + 64 * (j))
#define XB_XSUB(j)  (1280 + 64 * (j))
#define XB_XGEN(j)  (2304 + 64 * (j))
#define XB_TOP      3328
#define XB_TOPGEN   3392
#define XCD_BAR_WORDS 3456
#define XB_SPIN_CAP (1u << 22)
__device__ __forceinline__ unsigned xb_ld(unsigned* p)              { return __hip_atomic_load(p, __ATOMIC_RELAXED, __HIP_MEMORY_SCOPE_AGENT); }
__device__ __forceinline__ unsigned xb_add(unsigned* p, unsigned v) { return __hip_atomic_fetch_add(p, v, __ATOMIC_RELAXED, __HIP_MEMORY_SCOPE_AGENT); }
__device__ __forceinline__ unsigned xb_xcc_id() { return (unsigned)__builtin_amdgcn_s_getreg((3 << 11) | 20) & 0xFu; }
#define XB_SPIN(cond, bar) do { unsigned _sp = 0; while (cond) { __builtin_amdgcn_s_sleep(1); \
    if ((++_sp & 255u) == 0u) { if (xb_ld(&(bar)[XB_TMO])) break; if (_sp > XB_SPIN_CAP) { atomicAdd(&(bar)[XB_TMO], 1u); break; } } } } while (0)
struct XcdBarrier { unsigned* bar; unsigned x; volatile LAS unsigned* st; };
__device__ __forceinline__ XcdBarrier xcd_barrier_post(unsigned* bar, volatile LAS unsigned* st) {
    XcdBarrier b; b.bar = bar; b.x = xb_xcc_id(); b.st = st;
    if (threadIdx.x == 0) (void)xb_add(&bar[XB_XCNT(b.x)], 1u);
    return b;
}
__device__ __forceinline__ void xcd_barrier_complete(unsigned* bar, unsigned x, unsigned& nloc, unsigned& nx) {
    const unsigned G = gridDim.x * gridDim.y * gridDim.z;
    unsigned sum, cnt, mine, sp = 0u;
    for (;;) {
        sum = 0u; cnt = 0u; mine = 0u;
#pragma unroll
        for (unsigned j = 0; j < 16; ++j) { const unsigned c = xb_ld(&bar[XB_XCNT(j)]); sum += c; cnt += (c > 0u) ? 1u : 0u; mine = (j == x) ? c : mine; }
        if (sum == G) break;
        __builtin_amdgcn_s_sleep(1);
        if ((++sp & 255u) == 0u) { if (xb_ld(&bar[XB_TMO])) break; if (sp > XB_SPIN_CAP) { atomicAdd(&bar[XB_TMO], 1u); break; } }
    }
    nloc = mine > 0u ? mine : 1u; nx = cnt > 0u ? cnt : 1u;
}
__device__ __forceinline__ void xcd_barrier(const XcdBarrier& b) {
    asm volatile("s_waitcnt vmcnt(0)" ::: "memory");
    __syncthreads();
    if (threadIdx.x == 0) {
        unsigned* bar = b.bar;
        __builtin_amdgcn_s_waitcnt(0);
        unsigned nloc = b.st[0], nx = b.st[1];
        if (nloc == 0u) { xcd_barrier_complete(bar, b.x, nloc, nx); b.st[0] = nloc; b.st[1] = nx; }
        const unsigned old = xb_add(&bar[XB_XSUB(b.x)], 1u);
        const unsigned gen = old / nloc;
        if (old + 1u == (gen + 1u) * nloc) {
            __builtin_amdgcn_fence(__ATOMIC_RELEASE, "agent");
            asm volatile("s_waitcnt vmcnt(0)" ::: "memory");
            const unsigned og = xb_add(&bar[XB_TOP], 1u);
            const unsigned tg = og / nx;
            if (og + 1u == (tg + 1u) * nx) xb_add(&bar[XB_TOPGEN], 1u);
            else XB_SPIN(xb_ld(&bar[XB_TOPGEN]) == tg, bar);
            __builtin_amdgcn_fence(__ATOMIC_ACQUIRE, "agent");
            xb_add(&bar[XB_XGEN(b.x)], 1u);
            asm volatile("s_waitcnt vmcnt(0)" ::: "memory");
        } else {
            XB_SPIN(xb_ld(&bar[XB_XGEN(b.x)]) == gen, bar);
            __builtin_amdgcn_fence(__ATOMIC_ACQUIRE, "agent");
            asm volatile("s_waitcnt vmcnt(0)" ::: "memory");
        }
    }
    __syncthreads();
}

namespace pg8 {
constexpr int BM = 256, BK = 64, HALF = 128, HTB = HALF * BK * 2, NXCD = 8, WGM = 8;
__device__ __forceinline__ int lds_byte(int r, int c) { const int st = (r >> 4) * 2 + (c >> 5), rr = r & 15, cc = c & 31, ob = rr * 64 + cc * 2; return st * 1024 + (ob ^ (((ob >> 9) & 1) << 5)); }
__device__ __forceinline__ void stage_rc(int b, int& R, int& C) { const int st = b / 1024, sb = b % 1024, swz = sb ^ (((sb >> 9) & 1) << 5); R = (st >> 1) * 16 + swz / 64; C = (st & 1) * 32 + (swz % 64) / 2; }
__device__ __forceinline__ int perm32(int rho) { const int n = rho >> 4, i = rho & 15; return 8 * (i >> 2) + 4 * n + (i & 3); }
struct Unit { int pm, pn; const char* A; const char* B; };

template <class Epi, class Sched>
__device__ __forceinline__ void gemm_phase(LAS unsigned char* lds, const int K, const Sched& S, const Epi& E) {
    const int tid = opaque_tid(), wid = __builtin_amdgcn_readfirstlane(tid >> 6), lane = tid & 63, wr = wid >> 2, wc = wid & 3, fr = lane & 15, fq = lane >> 4;
    const int nt = K / BK;
    unsigned voffA[2], voffB[2];
#pragma unroll
    for (int i = 0; i < 2; ++i) { int R, C; stage_rc(tid * 16 + i * 8192, R, C); const int Rb = Epi::PERM ? ((R & ~31) + perm32(R & 31)) : R;
        voffA[i] = (unsigned)(R * K + C) * 2u; voffB[i] = (unsigned)(Rb * K + C) * 2u; }
    const size_t kstep = (size_t)(BK * 2);
    const size_t hstep = (size_t)HALF * K * 2;
    const unsigned ldsw = (unsigned)wid * 1024u;
    const int aoff = lds_byte(wr * 64 + fr, fq * 8), boff = lds_byte(wc * 32 + fr, fq * 8);
#define PG8_SA(b, h) (((b) * 2 + (h)) * HTB)
#define PG8_SB(b, h) ((4 + (b) * 2 + (h)) * HTB)
#define PG8_STAGE(bufoff, gbase, voff) do { _Pragma("unroll") for (int _i = 0; _i < 2; ++_i) \
        __builtin_amdgcn_global_load_lds((const unsigned*)((const char*)(gbase) + (voff)[_i]), (LAS unsigned*)(lds + (bufoff) + ldsw + _i * 8192), 16, 0, 0); } while (0)
#define PG8_LDA(dst, b, h) do { _Pragma("unroll") for (int m = 0; m < 4; ++m) _Pragma("unroll") for (int k = 0; k < 2; ++k) dst[m][k] = *(const LAS bf16x8*)(lds + PG8_SA(b, h) + aoff + m * 2048 + k * 1024); } while (0)
#define PG8_LDB(dst, b, h) do { _Pragma("unroll") for (int n = 0; n < 2; ++n) _Pragma("unroll") for (int k = 0; k < 2; ++k) dst[n][k] = *(const LAS bf16x8*)(lds + PG8_SB(b, h) + boff + n * 2048 + k * 1024); } while (0)
#define PG8_MMA(ai, bj, At, Bt) do { __builtin_amdgcn_s_setprio(1); _Pragma("unroll") for (int m = 0; m < 4; ++m) _Pragma("unroll") for (int n = 0; n < 2; ++n) _Pragma("unroll") for (int k = 0; k < 2; ++k) \
        acc[ai][bj][m][n] = __builtin_amdgcn_mfma_f32_16x16x32_bf16(Bt[n][k], At[m][k], acc[ai][bj][m][n], 0, 0, 0); __builtin_amdgcn_s_setprio(0); } while (0)
#define PG8_WAIT_V(n) asm volatile("s_waitcnt vmcnt(" #n ")" ::: "memory")
#define PG8_WAIT_L(n) asm volatile("s_waitcnt lgkmcnt(" #n ")" ::: "memory")
#define PG8_BAR __builtin_amdgcn_s_barrier()
#define PG8_SCHED __builtin_amdgcn_sched_barrier(0)
    Unit cur, nxt; int ui = 0;
    if (!S.next(0, cur)) return;
    f32x4 acc[2][2][4][2];
#pragma unroll
    for (int a = 0; a < 2; ++a)
#pragma unroll
        for (int b = 0; b < 2; ++b)
#pragma unroll
            for (int m = 0; m < 4; ++m)
#pragma unroll
                for (int n = 0; n < 2; ++n) acc[a][b][m][n] = (f32x4){0.f, 0.f, 0.f, 0.f};
    bf16x8 At[4][2], B0[2][2], B1[2][2];
    const char* cA = cur.A; const char* cB = cur.B;
    PG8_STAGE(PG8_SB(0, 0), cB, voffB); PG8_STAGE(PG8_SA(0, 0), cA, voffA); PG8_STAGE(PG8_SB(0, 1), cB + hstep, voffB); PG8_STAGE(PG8_SA(0, 1), cA + hstep, voffA);
    if (wr == 1) PG8_BAR;
    PG8_WAIT_V(4); PG8_BAR;
    PG8_STAGE(PG8_SB(1, 0), cB + kstep, voffB); PG8_STAGE(PG8_SA(1, 0), cA + kstep, voffA); PG8_STAGE(PG8_SB(1, 1), cB + hstep + kstep, voffB);
    PG8_WAIT_V(6); PG8_BAR;
    for (;;) {
        const bool has_next = S.next(ui + 1, nxt);
        const char* nA = has_next ? nxt.A : cA; const char* nB = has_next ? nxt.B : cB;
        for (int t = 0; t < nt; t += 2) {
            const bool last = (t == nt - 2);
            const char* a1 = cA + (size_t)(t + 1) * kstep;
            const char* a2 = last ? nA : cA + (size_t)(t + 2) * kstep; const char* b2 = last ? nB : cB + (size_t)(t + 2) * kstep;
            const char* a3 = a2 + kstep; const char* b3 = b2 + kstep;
            PG8_LDB(B0, 0, 0); PG8_SCHED; PG8_LDA(At, 0, 0); PG8_STAGE(PG8_SA(1, 1), a1 + hstep, voffA);
            PG8_WAIT_L(8); PG8_BAR; PG8_WAIT_L(0); PG8_MMA(0, 0, At, B0); PG8_BAR; PG8_SCHED;
            PG8_LDB(B1, 0, 1); PG8_STAGE(PG8_SB(0, 0), b2, voffB);
            PG8_BAR; PG8_WAIT_L(0); PG8_MMA(0, 1, At, B1); PG8_BAR;
            PG8_LDA(At, 0, 1); PG8_STAGE(PG8_SA(0, 0), a2, voffA);
            PG8_BAR; PG8_WAIT_L(0); PG8_MMA(1, 0, At, B0); PG8_BAR; PG8_SCHED;
            PG8_STAGE(PG8_SB(0, 1), b2 + hstep, voffB);
            PG8_WAIT_V(6); PG8_BAR; PG8_MMA(1, 1, At, B1); PG8_BAR;
            PG8_LDB(B0, 1, 0); PG8_SCHED; PG8_LDA(At, 1, 0); PG8_STAGE(PG8_SA(0, 1), a2 + hstep, voffA);
            PG8_WAIT_L(8); PG8_BAR; PG8_WAIT_L(0); PG8_MMA(0, 0, At, B0); PG8_BAR; PG8_SCHED;
            PG8_LDB(B1, 1, 1); PG8_STAGE(PG8_SB(1, 0), b3, voffB);
            PG8_BAR; PG8_WAIT_L(0); PG8_MMA(0, 1, At, B1); PG8_BAR;
            PG8_LDA(At, 1, 1); PG8_STAGE(PG8_SA(1, 0), a3, voffA);
            PG8_BAR; PG8_WAIT_L(0); PG8_MMA(1, 0, At, B0); PG8_BAR; PG8_SCHED;
            PG8_STAGE(PG8_SB(1, 1), b3 + hstep, voffB);
            PG8_WAIT_V(6); PG8_BAR; PG8_MMA(1, 1, At, B1); PG8_BAR;
        }
        E(acc, cur, wr, wc, fr, fq);
        if (!has_next) break;
#pragma unroll
        for (int a = 0; a < 2; ++a)
#pragma unroll
            for (int b = 0; b < 2; ++b)
#pragma unroll
                for (int m = 0; m < 4; ++m)
#pragma unroll
                    for (int n = 0; n < 2; ++n) acc[a][b][m][n] = (f32x4){0.f, 0.f, 0.f, 0.f};
        cur = nxt; cA = nA; cB = nB; ++ui;
    }
    PG8_WAIT_V(0);
    if (wr == 0) PG8_BAR;
    PG8_BAR;
#undef PG8_SA
#undef PG8_SB
#undef PG8_STAGE
#undef PG8_LDA
#undef PG8_LDB
#undef PG8_MMA
#undef PG8_WAIT_V
#undef PG8_WAIT_L
#undef PG8_BAR
#undef PG8_SCHED
}

struct SchedDense {
    int nM, nN, nwg, G, c; const char* A; const char* Bt; size_t tstep;
    __device__ __forceinline__ void init(int M, int N, int K, int G_, int c_, const void* A_, const void* Bt_) { nM = M / BM; nN = N / BM; nwg = nM * nN; G = G_; c = c_; A = (const char*)A_; Bt = (const char*)Bt_; tstep = (size_t)BM * K * 2; }
    __device__ __forceinline__ bool next(int i, Unit& u) const {
        const long L = (long)i * G + c; if (L >= nwg) return false;
        int wgid = (int)L; { const int q = nwg / NXCD, r = nwg % NXCD, xcd = wgid % NXCD, off = wgid / NXCD; wgid = (xcd < r ? xcd * (q + 1) : r * (q + 1) + (xcd - r) * q) + off; }
        const int nig = WGM * nN, gid = wgid / nig, fm = gid * WGM, gsz = (nM - fm) < WGM ? (nM - fm) : WGM;
        u.pm = fm + ((wgid % nig) % gsz); u.pn = (wgid % nig) / gsz;
        u.A = A + (size_t)u.pm * tstep; u.B = Bt + (size_t)u.pn * tstep; return true;
    }
};
struct SchedMoe1 {
    int c; bool has_ctx; const char* xe; const char* wgu; size_t tstep;
    __device__ __forceinline__ bool next(int i, Unit& u) const {
        int g, pn;
        if (i < 8) { const int q = i * 8 + (c & 7), j = c >> 3; g = q >> 1; u.pm = g * 8 + 4 * (q & 1) + (j & 3); pn = j >> 2; }
        else if (has_ctx && i == 8) { g = c >> 3; pn = c & 7; u.pm = 256 + g; }
        else return false;
        u.pn = pn; u.A = xe + (size_t)u.pm * tstep; u.B = wgu + ((size_t)(g & 15) * 8 + pn) * tstep; return true;
    }
};
struct SchedMoe2 {
    int c; bool has_ctx; const char* hid; const char* wd; size_t tstep;
    __device__ __forceinline__ bool next(int i, Unit& u) const {
        int g, pn;
        if (i < 4) { const int j = c >> 3; g = i * 8 + (c & 7); u.pm = g * 8 + (j & 7); pn = j >> 3; }
        else if (has_ctx && i == 4 && c < 128) { g = c >> 2; pn = c & 3; u.pm = 256 + g; }
        else return false;
        u.pn = pn; u.A = hid + (size_t)u.pm * tstep; u.B = wd + ((size_t)(g & 15) * 4 + pn) * tstep; return true;
    }
};

struct EpiBf16Plain {
    static constexpr bool PERM = true;
    bf16_t* O; int ldc;
    __device__ __forceinline__ void operator()(const f32x4 (&acc)[2][2][4][2], const Unit& u, int wr, int wc, int fr, int fq) const {
        const int row0 = u.pm * BM + wr * 64 + fr, col0 = u.pn * BM + wc * 32 + 8 * fq;
#pragma unroll
        for (int ai = 0; ai < 2; ++ai)
#pragma unroll
            for (int m = 0; m < 4; ++m) { bf16_t* rowp = O + (size_t)(row0 + ai * HALF + m * 16) * ldc + col0;
#pragma unroll
                for (int bj = 0; bj < 2; ++bj) { const f32x4 v0 = acc[ai][bj][m][0], v1 = acc[ai][bj][m][1];
                    u32x4 w; w.x = cvt_pk(v0[0], v0[1]); w.y = cvt_pk(v0[2], v0[3]); w.z = cvt_pk(v1[0], v1[1]); w.w = cvt_pk(v1[2], v1[3]);
                    *(u32x4*)(rowp + bj * HALF) = w; } }
    }
};
struct EpiResid {
    static constexpr bool PERM = false;
    float* hlat; float* hctx; const float* mods_l;
    __device__ __forceinline__ void operator()(const f32x4 (&acc)[2][2][4][2], const Unit& u, int wr, int wc, int fr, int fq) const {
        const int rowt = u.pm * BM;
        float* base; int s;
        if (rowt < LAT) { base = hlat + (size_t)rowt * D; s = rowt / T; } else { base = hctx + (size_t)(rowt - LAT) * D; s = 2; }
        const float* g1 = mods_l + s * 6144 + 2048;
        const int r0 = wr * 64 + fr, col0 = u.pn * BM + wc * 32 + 4 * fq;
        f32x4 gv[2][2];
#pragma unroll
        for (int bj = 0; bj < 2; ++bj)
#pragma unroll
            for (int n = 0; n < 2; ++n) gv[bj][n] = *(const f32x4*)(g1 + col0 + bj * HALF + n * 16);
#pragma unroll
        for (int ai = 0; ai < 2; ++ai)
#pragma unroll
            for (int m = 0; m < 4; ++m) { float* rowp = base + (size_t)(r0 + ai * HALF + m * 16) * D + col0;
#pragma unroll
                for (int bj = 0; bj < 2; ++bj)
#pragma unroll
                    for (int n = 0; n < 2; ++n) { f32x4* p = (f32x4*)(rowp + bj * HALF + n * 16); *p = *p + gv[bj][n] * acc[ai][bj][m][n]; } }
    }
};
struct EpiSwiglu {
    static constexpr bool PERM = true;
    bf16_t* hid;
    __device__ __forceinline__ void operator()(const f32x4 (&acc)[2][2][4][2], const Unit& u, int wr, int wc, int fr, int fq) const {
        const int row0 = u.pm * BM + wr * 64 + fr, f0 = u.pn * HALF + wc * 32 + 8 * fq;
#pragma unroll
        for (int ai = 0; ai < 2; ++ai)
#pragma unroll
            for (int m = 0; m < 4; ++m) { bf16_t* rowp = hid + (size_t)(row0 + ai * HALF + m * 16) * D + f0;
                float o[8];
#pragma unroll
                for (int n = 0; n < 2; ++n)
#pragma unroll
                    for (int j = 0; j < 4; ++j) { const float g = acc[ai][0][m][n][j], up = acc[ai][1][m][n][j]; o[n * 4 + j] = g / (1.0f + __expf(-g)) * up; }
                u32x4 w; w.x = cvt_pk(o[0], o[1]); w.y = cvt_pk(o[2], o[3]); w.z = cvt_pk(o[4], o[5]); w.w = cvt_pk(o[6], o[7]);
                *(u32x4*)rowp = w; }
    }
};
struct EpiScaleRow {
    static constexpr bool PERM = true;
    bf16_t* O; const float* gate;
    __device__ __forceinline__ void operator()(const f32x4 (&acc)[2][2][4][2], const Unit& u, int wr, int wc, int fr, int fq) const {
        const int row0 = u.pm * BM + wr * 64 + fr, col0 = u.pn * BM + wc * 32 + 8 * fq;
#pragma unroll
        for (int ai = 0; ai < 2; ++ai)
#pragma unroll
            for (int m = 0; m < 4; ++m) { const int row = row0 + ai * HALF + m * 16; const float gs = gate[row]; bf16_t* rowp = O + (size_t)row * D + col0;
#pragma unroll
                for (int bj = 0; bj < 2; ++bj) { const f32x4 v0 = acc[ai][bj][m][0] * gs, v1 = acc[ai][bj][m][1] * gs;
                    u32x4 w; w.x = cvt_pk(v0[0], v0[1]); w.y = cvt_pk(v0[2], v0[3]); w.z = cvt_pk(v1[0], v1[1]); w.w = cvt_pk(v1[2], v1[3]);
                    *(u32x4*)(rowp + bj * HALF) = w; } }
    }
};
}

template <int K>
__device__ __forceinline__ f32x4 mm16(const unsigned char* X, int ldx, int x0, const unsigned char* Y, int ldy, int y0, f32x4 acc, int lane) {
    const int r = lane & 15, g = lane >> 4;
#pragma unroll
    for (int k0 = 0; k0 < K; k0 += 32) {
        const bf16x8 xf = *(const bf16x8*)(X + ((size_t)(x0 + r) * ldx + k0 + 8 * g) * 2);
        const bf16x8 yf = *(const bf16x8*)(Y + ((size_t)(y0 + r) * ldy + k0 + 8 * g) * 2);
        acc = __builtin_amdgcn_mfma_f32_16x16x32_bf16(yf, xf, acc, 0, 0, 0);
    }
    return acc;
}
#define SL(i) (smem + (i) * SLOT)
__device__ __forceinline__ void st_row4(unsigned char* M, int x, int y, f32x4 v) { u32x2 w; w.x = cvt_pk(v[0], v[1]); w.y = cvt_pk(v[2], v[3]); *(u32x2*)(M + ((size_t)x * 72 + y) * 2) = w; }
__device__ __forceinline__ void st_col4(unsigned char* M, int x, int y, f32x4 v) {
#pragma unroll
    for (int j = 0; j < 4; ++j) *(bf16_t*)(M + ((size_t)(y + j) * 72 + x) * 2) = f2bf(v[j]);
}
__device__ __forceinline__ f32x4 ld_row4(const unsigned char* M, int x, int y) { const u32x2 w = *(const u32x2*)(M + ((size_t)x * 72 + y) * 2);
    return (f32x4){bf2f(w.x & 0xffffu), bf2f(w.x >> 16), bf2f(w.y & 0xffffu), bf2f(w.y >> 16)}; }
__device__ __forceinline__ void unpack8(const bf16x8 v, float* o) {
#pragma unroll
    for (int j = 0; j < 8; ++j) o[j] = bf2f((unsigned short)v[j]);
}
__device__ __forceinline__ bf16x8 pack8(const float* o) { u32x4 w; w.x = cvt_pk(o[0], o[1]); w.y = cvt_pk(o[2], o[3]); w.z = cvt_pk(o[4], o[5]); w.w = cvt_pk(o[6], o[7]); return __builtin_bit_cast(bf16x8, w); }

__device__ __forceinline__ void conv8(const bf16_t* p, const float* sw  , int row, int lo, int hi, int col, float* u) {
#pragma unroll
    for (int j = 0; j < 8; ++j) u[j] = 0.f;
#pragma unroll
    for (int dt = 0; dt < 3; ++dt) {
        const int rr = row + dt - 1;
        if (rr >= lo && rr < hi) {
            const bf16x8 x = *(const bf16x8*)(p + (size_t)rr * INC + col);
            const f32x4 w0 = *(const f32x4*)(sw + dt * 1792 + col), w1 = *(const f32x4*)(sw + dt * 1792 + col + 4);
            float xf[8]; unpack8(x, xf);
#pragma unroll
            for (int j = 0; j < 4; ++j) { u[j] += xf[j] * w0[j]; u[4 + j] += xf[4 + j] * w1[j]; }
        }
    }
}
__device__ __forceinline__ f32x4 conv4(const bf16_t* p, const float* sw, int row, int lo, int hi, int col) {
    f32x4 u = {0.f, 0.f, 0.f, 0.f};
#pragma unroll
    for (int dt = 0; dt < 3; ++dt) {
        const int rr = row + dt - 1;
        if (rr >= lo && rr < hi) {
            const u32x2 x = *(const u32x2*)(p + (size_t)rr * INC + col);
            const f32x4 w = *(const f32x4*)(sw + dt * 1792 + col);
            u[0] += bf2f(x.x & 0xffffu) * w[0]; u[1] += bf2f(x.x >> 16) * w[1]; u[2] += bf2f(x.y & 0xffffu) * w[2]; u[3] += bf2f(x.y >> 16) * w[3];
        }
    }
    return u;
}

__device__ __forceinline__ void ph_mods(const Params& P0, unsigned char* smem, int bid, int nblk) {
    const Params P = launder(P0);
    const int tid = opaque_tid();
    float* sil = (float*)smem;
    float* red = (float*)(smem + 12288);
    for (int i = tid; i < 3072; i += NT) { const float x = (i < 2048) ? P.in[1][i] : P.in[3][i - 2048]; sil[i] = x / (1.0f + __expf(-x)); }
    __syncthreads();
    float* mods = (float*)(P.ws + OFF_MODS);
    const int c = tid & 15, ks = tid >> 4;
    for (int item = bid; item < 768; item += nblk) {
        const int l = item / 384, col = (item % 384) * 16 + c;
        const float* w = P.in[4] + (size_t)l * D * 6144 + col;
        float a0 = 0.f, a1 = 0.f, a2 = 0.f;
        for (int k = ks * 32; k < ks * 32 + 32; ++k) { const float wv = w[(size_t)k * 6144]; a0 += sil[k] * wv; a1 += sil[1024 + k] * wv; a2 += sil[2048 + k] * wv; }
        red[(ks * 16 + c) * 3 + 0] = a0; red[(ks * 16 + c) * 3 + 1] = a1; red[(ks * 16 + c) * 3 + 2] = a2;
        __syncthreads();
        if (tid < 48) { const int s = tid >> 4, cc = tid & 15; float sum = 0.f;
            for (int q = 0; q < 32; ++q) sum += red[(q * 16 + cc) * 3 + s];
            const int colo = (item % 384) * 16 + cc;
            mods[(size_t)(l * 3 + s) * 6144 + colo] = sum + P.in[5][l * 6144 + colo]; }
        __syncthreads();
    }
}
__device__ __forceinline__ void transpose_tile(const float* src, int N, bf16_t* dst, int dld, int kind, int tk, int tn, unsigned char* smem) {
    const int tid = opaque_tid();
    float* tile = (float*)smem;
#pragma unroll
    for (int i = 0; i < 2; ++i) { const int e = tid + i * NT, kk = e >> 4, n4 = (e & 15) * 4;
        const f32x4 v = *(const f32x4*)(src + (size_t)(tk * 64 + kk) * N + tn * 64 + n4);
        tile[kk * 65 + n4] = v[0]; tile[kk * 65 + n4 + 1] = v[1]; tile[kk * 65 + n4 + 2] = v[2]; tile[kk * 65 + n4 + 3] = v[3]; }
    __syncthreads();
    { const int n = tid >> 3, k8 = (tid & 7) * 8; float o[8];
#pragma unroll
      for (int j = 0; j < 8; ++j) o[j] = tile[(k8 + j) * 65 + n];
      const int ng = tn * 64 + n; int row = ng; if (kind == 1) row = (ng >> 7) * 256 + (ng & 127); else if (kind == 2) row = (ng >> 7) * 256 + 128 + (ng & 127);
      *(bf16x8*)(dst + (size_t)row * dld + tk * 64 + k8) = pack8(o); }
    __syncthreads();
}
__device__ __forceinline__ void ph_prep_weights(const Params& P0, unsigned char* smem, int bid, int nblk) {
    const Params P = launder(P0);
    for (int t = bid; t < 2 * 576; t += nblk) { const int l = t / 576, r = t % 576, tk = r / 36, tn = r % 36;
        transpose_tile(P.in[8] + (size_t)l * D * INC, INC, (bf16_t*)(P.ws + OFF_WINT) + (size_t)l * INC * D, D, 0, tk, tn, smem); }
    for (int t = bid; t < 2 * 128; t += nblk) { const int l = t / 128, r = t % 128, tk = r / 16, tn = r % 16;
        transpose_tile(P.in[23] + (size_t)l * D * D, D, (bf16_t*)(P.ws + OFF_WOT) + (size_t)l * D * MIXK, MIXK, 0, tk, tn, smem); }
    for (int t = bid; t < 64; t += nblk) { const int which = t / 32, r = t % 32, m = r / 8, tn = r % 8;
        transpose_tile((which ? P.in[13] : P.in[11]) + (size_t)m * 64 * 512, 512, (bf16_t*)(P.ws + (which ? OFF_IUPT : OFF_DUPT)) + (size_t)m * 512 * 64, 64, 0, 0, tn, smem); }
    for (int t = bid; t < 32; t += nblk) { const int l = t / 16, r = t % 16, tk = r / 8, tn = r % 8;
        transpose_tile(P.in[14] + (size_t)l * 128 * 512, 512, (bf16_t*)(P.ws + OFF_GUPT) + (size_t)l * 512 * 128, 128, 0, tk, tn, smem); }
}
__device__ __forceinline__ void ph_tables(const Params& P0, int bid, int nblk) {
    const Params P = launder(P0);
    const int gt = bid * NT + opaque_tid(), ngt = nblk * NT;
    bf16_t* D1 = (bf16_t*)(P.ws + OFF_D1); bf16_t* DC = (bf16_t*)(P.ws + OFF_DCTX); bf16_t* E2 = (bf16_t*)(P.ws + OFF_E2);
    for (int i = gt; i < 256 * 128; i += ngt) { const int m = i >> 7, t1 = i & 127, k1 = m & 127, ph = (k1 * t1) & 127; float s, c; sincospif((float)ph * (1.0f / 64.0f), &s, &c);
        D1[i] = f2bf((m < 128 ? c : -s) * (1.0f / 32.0f)); }
    for (int i = gt; i < 512 * 256; i += ngt) { const int m = i >> 8, t = i & 255, k = m & 255, ph = (k * t) & 255; float s, c; sincospif((float)ph * (1.0f / 128.0f), &s, &c);
        DC[i] = f2bf((m < 256 ? c : -s) * (1.0f / 128.0f)); }
    for (int i = gt; i < 128 * 256 * 256; i += ngt) { const int k1 = i >> 16, m = (i >> 8) & 255, kk = i & 255, k2 = m & 127, t2 = kk & 127, ph = (t2 * (k1 + 128 * k2)) & 16383;
        float s, c; sincospif((float)ph * (1.0f / 8192.0f), &s, &c);
        const float v = (m < 128) ? (kk < 128 ? c : s) : (kk < 128 ? -s : c);
        E2[i] = f2bf(v * (1.0f / 32.0f)); }
    float* wcs = (float*)(P.ws + OFF_WCS);
    for (int i = gt; i < 2 * 4 * 2 * 64 * 64; i += ngt) { const int d = i & 63, c = (i >> 6) & 63, reim = (i >> 12) & 1, lh = i >> 13;
        const float* fw = P.in[22] + (size_t)lh * 4096; float acc = 0.f;
        for (int m = 0; m < 64; ++m) { float s, cs; sincospif((float)((c * m) & 63) * (1.0f / 32.0f), &s, &cs); acc += (reim ? s : cs) * fw[m * 64 + d]; }
        wcs[i] = acc; }
}
__device__ __forceinline__ void ph_fold(const Params& P0, int bid, int nblk) {
    const Params P = launder(P0);
    const float* wcs = (const float*)(P.ws + OFF_WCS);
    for (int item = bid; item < 2 * 768 * 2; item += nblk) {
        const int nh = item & 1, k = 512 + (item >> 1) % 768, l = (item >> 1) / 768, n = nh * 512 + opaque_tid();
        const float* wo = P.in[23] + (size_t)l * D * D;
        float acc = 0.f;
        if (k < 768) { const int g = (k - 512) >> 6, cc = (k - 512) & 63;
            const float* pw = P.in[20] + ((size_t)(l * 4 + g) * 64 + cc) * 64; const float* ps = P.in[21] + l * 256 + g * 64;
            for (int d = 0; d < 64; ++d) acc += pw[d] * ps[d] * wo[(size_t)(512 + g * 64 + d) * D + n];
        } else { const int hh = (k - 768) >> 7, reim = ((k - 768) >> 6) & 1, c = (k - 768) & 63;
            const float* wc = wcs + ((size_t)((l * 4 + hh) * 2 + reim) * 64 + c) * 64;
            for (int d = 0; d < 64; ++d) acc += wc[d] * wo[(size_t)(768 + hh * 64 + d) * D + n];
        }
        ((bf16_t*)(P.ws + OFF_WOT))[((size_t)l * D + n) * MIXK + k] = f2bf(acc);
    }
}
__device__ __forceinline__ void ph_norm1(const Params& P0, int mode, int bid, int nblk) {
    const Params P = launder(P0);
    const int lane = opaque_tid() & 63, gw = bid * 8 + (opaque_tid() >> 6), ngw = nblk * 8;
    const float* mods = (const float*)(P.ws + OFF_MODS);
    float* hctx = (float*)(P.ws + OFF_HCTX);
    const int* inv = (const int*)(P.ws + OFF_INV);
    const bf16_t* ye = (const bf16_t*)(P.ws + OFF_XE);
    bf16_t* xn = (bf16_t*)(P.ws + OFF_XN);
    const int nrows = (mode == 2) ? LAT : MT;
    const int lcur = (mode == 2) ? 1 : mode, lprev = lcur - (mode == 2 ? 0 : 1);
    const float* gn = (mode == 2) ? P.in[28] : P.in[6] + lcur * D;
    for (int r = gw; r < nrows; r += ngw) {
        const int s = (r < LAT) ? r / T : 2;
        float* hrow = (r < LAT) ? P.out + (size_t)r * D : hctx + (size_t)(r - LAT) * D;
        const float* src = (mode == 0) ? ((r < LAT) ? P.in[0] + (size_t)r * D : P.in[2] + (size_t)(r - LAT) * D) : hrow;
        f32x4 v[4];
#pragma unroll
        for (int i = 0; i < 4; ++i) v[i] = *(const f32x4*)(src + 4 * lane + 256 * i);
        if (mode != 0) {
            const int iv = inv[(size_t)r * 16 + (lane & 15)];
            f32x4 a[4] = {{0.f, 0.f, 0.f, 0.f}, {0.f, 0.f, 0.f, 0.f}, {0.f, 0.f, 0.f, 0.f}, {0.f, 0.f, 0.f, 0.f}};
            for (int e = 0; e < 16; ++e) { const int slot = __shfl(iv, e);
                if (slot >= 0) { const size_t yrow = (r < LAT) ? (size_t)((r / T) * 16 + e) * 2048 + slot : (size_t)65536 + (size_t)(((r - LAT) / TC) * 16 + e) * 256 + slot;
#pragma unroll
                    for (int i = 0; i < 4; ++i) { const u32x2 w = *(const u32x2*)(ye + yrow * D + 4 * lane + 256 * i);
                        a[i][0] += bf2f(w.x & 0xffffu); a[i][1] += bf2f(w.x >> 16); a[i][2] += bf2f(w.y & 0xffffu); a[i][3] += bf2f(w.y >> 16); } } }
            const float* g2 = mods + (size_t)(lprev * 3 + s) * 6144 + 5120;
#pragma unroll
            for (int i = 0; i < 4; ++i) v[i] = v[i] + *(const f32x4*)(g2 + 4 * lane + 256 * i) * a[i];
        }
        if (mode != 2) {
#pragma unroll
            for (int i = 0; i < 4; ++i) *(f32x4*)(hrow + 4 * lane + 256 * i) = v[i];
        }
        float ss = 0.f;
#pragma unroll
        for (int i = 0; i < 4; ++i) ss += (v[i][0] * v[i][0] + v[i][1] * v[i][1]) + (v[i][2] * v[i][2] + v[i][3] * v[i][3]);
        const float rs = rsqrtf(wave_sum(ss) * (1.0f / D) + 1e-6f);
        if (mode == 2) {
#pragma unroll
            for (int i = 0; i < 4; ++i) *(f32x4*)(hrow + 4 * lane + 256 * i) = v[i] * rs * *(const f32x4*)(gn + 4 * lane + 256 * i);
        } else {
            const float* sh = mods + (size_t)(lcur * 3 + s) * 6144, *sc = sh + 1024;
#pragma unroll
            for (int i = 0; i < 4; ++i) { const int c = 4 * lane + 256 * i;
                const f32x4 y = v[i] * rs * *(const f32x4*)(gn + c) * (*(const f32x4*)(sc + c) + 1.0f) + *(const f32x4*)(sh + c);
                u32x2 w; w.x = cvt_pk(y[0], y[1]); w.y = cvt_pk(y[2], y[3]); *(u32x2*)(xn + (size_t)r * D + c) = w; }
        }
    }
}

__device__ __forceinline__ void ph_sa(const Params& P0, int l, int b, unsigned char* smem, int bid, int nblk) {
    const Params P = launder(P0);
    const int tid = opaque_tid(), lane = tid & 63, wid = tid >> 6, r = lane & 15, g = lane >> 4;
    const bf16_t* p = (const bf16_t*)(P.ws + OFF_P);
    const float* sw = P.in[9] + (size_t)l * 3 * 1792;
    float* LW = (float*)(smem + LDS_LW); float* SEG = (float*)(smem + LDS_SEG); float* GL = (float*)(smem + LDS_GL); float* BON = (float*)(smem + LDS_BON);
    float* bonus = (float*)(P.ws + OFF_BONUS);
    const int tx = wid & 3, ty0 = (wid >> 2) * 2;
    for (int q = bid; q < 4160; q += nblk) {
        const int h = q / 520, rem = q % 520, d = rem / 260, n = rem % 260;
        int tok0, lo, hi;
        if (n < 4) { lo = LAT + b * TC; hi = lo + TC; tok0 = lo + 64 * (d ? 3 - n : n); }
        else { lo = b * T; hi = lo + T; tok0 = lo + 64 * (d ? 255 - (n - 4) : (n - 4)); }
        unsigned char* gout = P.ws + OFF_SCAN + (size_t)((h * 2 + d) * 260 + n) * 32768;
        { const int t = tid >> 3, c8 = (tid & 7) * 8, row = tok0 + t; float u[8], kk[8];
          conv8(p, sw, row, lo, hi, h * 64 + c8, u); *(bf16x8*)(SL(8) + (t * 72 + c8) * 2) = pack8(u);
          conv8(p, sw, row, lo, hi, 512 + h * 64 + c8, u); *(bf16x8*)(SL(9) + (t * 72 + c8) * 2) = pack8(u);
          { const f32x4 k0 = *(const f32x4*)(P.in[15] + l * 512 + h * 64 + c8), k1 = *(const f32x4*)(P.in[15] + l * 512 + h * 64 + c8 + 4); float ss = 0.f;
#pragma unroll
            for (int j = 0; j < 8; ++j) { kk[j] = u[j] * (j < 4 ? k0[j] : k1[j - 4]); ss += kk[j] * kk[j]; }
            ss += __shfl_xor(ss, 1); ss += __shfl_xor(ss, 2); ss += __shfl_xor(ss, 4);
            const float inv = rsqrtf(ss + 1e-12f);
#pragma unroll
            for (int j = 0; j < 8; ++j) kk[j] *= inv;
            *(bf16x8*)(SL(10) + (t * 72 + c8) * 2) = pack8(kk); }
          conv8(p, sw, row, lo, hi, 1024 + h * 64 + c8, u); *(bf16x8*)(SL(11) + (t * 72 + c8) * 2) = pack8(u);
          conv8(p, sw, row, lo, hi, 1536 + c8, u);
#pragma unroll
          for (int j = 0; j < 8; ++j) u[j] = tanhf(u[j]);
          *(bf16x8*)(SL(12) + (t * 72 + c8) * 2) = pack8(u);
          conv8(p, sw, row, lo, hi, 1600 + c8, u); *(bf16x8*)(SL(13) + (t * 72 + c8) * 2) = pack8(u);
          if (tid < 64) BON[tid] = 0.f; }
        __syncthreads();
        { const bf16_t* dupT = (const bf16_t*)(P.ws + OFF_DUPT) + (size_t)((l * 2 + d) * 512 + h * 64) * 64;
          const bf16_t* iupT = (const bf16_t*)(P.ws + OFF_IUPT) + (size_t)((l * 2 + d) * 512 + h * 64) * 64;
          const int t = 16 * tx + r; float bon = 0.f;
#pragma unroll
          for (int tyi = 0; tyi < 2; ++tyi) { const int cy = ty0 + tyi;
            f32x4 aw = {0.f, 0.f, 0.f, 0.f}, aa = {0.f, 0.f, 0.f, 0.f};
#pragma unroll
            for (int k0 = 0; k0 < 64; k0 += 32) {
                const bf16x8 xw = *(const bf16x8*)(SL(12) + ((size_t)t * 72 + k0 + 8 * g) * 2), xa = *(const bf16x8*)(SL(13) + ((size_t)t * 72 + k0 + 8 * g) * 2);
                const bf16x8 yw = *(const bf16x8*)(dupT + (size_t)(16 * cy + r) * 64 + k0 + 8 * g), ya = *(const bf16x8*)(iupT + (size_t)(16 * cy + r) * 64 + k0 + 8 * g);
                aw = __builtin_amdgcn_mfma_f32_16x16x32_bf16(yw, xw, aw, 0, 0, 0); aa = __builtin_amdgcn_mfma_f32_16x16x32_bf16(ya, xa, aa, 0, 0, 0); }
            const int c = 16 * cy + 4 * g, hc = h * 64 + c;
            const f32x4 w0 = *(const f32x4*)(P.in[10] + (l * 2 + d) * 512 + hc), a0 = *(const f32x4*)(P.in[12] + (l * 2 + d) * 512 + hc);
            const f32x4 ka = *(const f32x4*)(P.in[16] + l * 512 + hc), rk = *(const f32x4*)(P.in[17] + l * 512 + hc);
            const f32x4 kv = ld_row4(SL(9), t, c), kkv = ld_row4(SL(10), t, c), rv = ld_row4(SL(8), t, c);
            f32x4 lw, kd, bb;
#pragma unroll
            for (int j = 0; j < 4; ++j) { const float x = -(w0[j] + aw[j]); const float sp = (x > 20.f) ? x : log1pf(__expf(x));
                lw[j] = -__expf(-sp - 0.5f);
                const float al = sigmoidf_(a0[j] + aa[j]);
                kd[j] = kv[j] * (1.0f + (al - 1.0f) * ka[j]); bb[j] = kkv[j] * al; bon += rv[j] * kd[j] * rk[j]; }
            *(f32x4*)(LW + t * 68 + c) = lw;
            st_row4(SL(9), t, c, kd); st_row4(SL(2), t, c, bb); }
          bon += __shfl_xor(bon, 16); bon += __shfl_xor(bon, 32);
          if (g == 0) atomicAdd(&BON[t], bon); }
        __syncthreads();
        if (tid < 64) bonus[((size_t)d * MT + tok0 + tid) * 8 + h] = BON[tid];
        { const int c = tid & 63, sg = tid >> 6; float lwv[8], cum[8]; float run = 0.f;
#pragma unroll
          for (int qq = 0; qq < 8; ++qq) { const int i = 8 * sg + qq, tl = d ? 63 - i : i; lwv[qq] = LW[tl * 68 + c]; run += lwv[qq]; cum[qq] = run; }
          SEG[sg * 64 + c] = run;
          float kkv[8], rv[8], kdv[8], bbv[8], vv[8];
#pragma unroll
          for (int qq = 0; qq < 8; ++qq) { const int i = 8 * sg + qq, tl = d ? 63 - i : i;
              rv[qq] = bf2f(*(const bf16_t*)(SL(8) + (tl * 72 + c) * 2)); kdv[qq] = bf2f(*(const bf16_t*)(SL(9) + (tl * 72 + c) * 2));
              kkv[qq] = bf2f(*(const bf16_t*)(SL(10) + (tl * 72 + c) * 2)); vv[qq] = bf2f(*(const bf16_t*)(SL(11) + (tl * 72 + c) * 2));
              bbv[qq] = bf2f(*(const bf16_t*)(SL(2) + (tl * 72 + c) * 2)); }
          __syncthreads();
          float off = 0.f, tot = 0.f;
#pragma unroll
          for (int s2 = 0; s2 < 8; ++s2) { const float sv = SEG[s2 * 64 + c]; tot += sv; off += (s2 < sg) ? sv : 0.f; }
          float oat[8], obh[8], okh[8];
#pragma unroll
          for (int qq = 0; qq < 8; ++qq) { const int i = 8 * sg + qq; const float cm = off + cum[qq];
              const float e = __expf(cm), einv = __expf(-cm), eprev = __expf(cm - lwv[qq]), eh = __expf(tot - cm);
              oat[qq] = -kkv[qq] * eprev; obh[qq] = bbv[qq] * eh; okh[qq] = kdv[qq] * eh;
              *(bf16_t*)(SL(0) + (i * 72 + c) * 2) = f2bf(oat[qq]);
              *(bf16_t*)(SL(2) + (i * 72 + c) * 2) = f2bf(bbv[qq] * einv);
              *(bf16_t*)(SL(3) + (i * 72 + c) * 2) = f2bf(kdv[qq] * einv);
              *(bf16_t*)(SL(4) + (i * 72 + c) * 2) = f2bf(rv[qq] * e); }
          *(bf16x8*)(SL(1) + (c * 72 + 8 * sg) * 2) = pack8(oat);
          *(bf16x8*)(SL(5) + (c * 72 + 8 * sg) * 2) = pack8(obh);
          *(bf16x8*)(SL(6) + (c * 72 + 8 * sg) * 2) = pack8(okh);
          *(bf16x8*)(SL(7) + (c * 72 + 8 * sg) * 2) = pack8(vv);
          if (sg == 0) GL[c] = __expf(tot); }
        __syncthreads();
        const f32x4 zero = {0.f, 0.f, 0.f, 0.f};
        const int x = 16 * tx + r;
#pragma unroll
        for (int tyi = 0; tyi < 2; ++tyi) { const int ty = ty0 + tyi, y = 16 * ty + 4 * g;
            f32x4 a = mm16<64>(SL(0), 72, 16 * tx, SL(2), 72, 16 * ty, zero, lane);
            f32x4 tt;
#pragma unroll
            for (int j = 0; j < 4; ++j) { a[j] = (x > y + j) ? a[j] : 0.f; tt[j] = a[j] + ((x == y + j) ? 1.0f : 0.f); }
            st_row4(SL(8), x, y, a); st_col4(SL(9), x, y, a); st_row4(SL(13), x, y, tt);
            a = mm16<64>(SL(3), 72, 16 * tx, SL(0), 72, 16 * ty, zero, lane);
#pragma unroll
            for (int j = 0; j < 4; ++j) a[j] = (x < y + j) ? a[j] : 0.f;
            st_row4(SL(10), x, y, a);
            a = mm16<64>(SL(4), 72, 16 * tx, SL(2), 72, 16 * ty, zero, lane);
#pragma unroll
            for (int j = 0; j < 4; ++j) a[j] = (y + j <= x) ? a[j] : 0.f;
            st_row4(SL(11), x, y, a);
            a = mm16<64>(SL(4), 72, 16 * tx, SL(3), 72, 16 * ty, zero, lane);
#pragma unroll
            for (int j = 0; j < 4; ++j) a[j] = (y + j <= x) ? a[j] : 0.f;
            st_row4(SL(12), x, y, a); }
        __syncthreads();
#define SQ(xs, ys, on, om) do { _Pragma("unroll") for (int tyi = 0; tyi < 2; ++tyi) { const int ty = ty0 + tyi, y = 16 * ty + 4 * g; \
            const f32x4 a = mm16<64>(SL(xs), 72, 16 * tx, SL(ys), 72, 16 * ty, zero, lane); st_row4(SL(on), x, y, a); st_col4(SL(om), x, y, a); } } while (0)
#define TU(xs, ys, os) do { _Pragma("unroll") for (int tyi = 0; tyi < 2; ++tyi) { const int ty = ty0 + tyi, y = 16 * ty + 4 * g; \
            const f32x4 a = mm16<64>(SL(xs), 72, 16 * tx, SL(ys), 72, 16 * ty, ld_row4(SL(xs), x, y), lane); st_row4(SL(os), x, y, a); } } while (0)
        SQ(8, 9, 0, 2); __syncthreads();
        TU(13, 2, 3); SQ(0, 2, 8, 9); __syncthreads();
        TU(3, 9, 13); SQ(8, 9, 0, 2); __syncthreads();
        TU(13, 2, 3); SQ(0, 2, 8, 9); __syncthreads();
        TU(3, 9, 13); __syncthreads();
#undef SQ
#undef TU
#pragma unroll
        for (int tyi = 0; tyi < 2; ++tyi) { const int ty = ty0 + tyi, y = 16 * ty + 4 * g;
            st_row4(SL(0), x, y, mm16<64>(SL(1), 72, 16 * tx, SL(13), 72, 16 * ty, zero, lane));
            st_row4(SL(2), x, y, mm16<64>(SL(10), 72, 16 * tx, SL(13), 72, 16 * ty, zero, lane)); }
        __syncthreads();
#pragma unroll
        for (int tyi = 0; tyi < 2; ++tyi) { const int ty = ty0 + tyi, y = 16 * ty + 4 * g;
            const size_t coff = ((size_t)((tx * 2 + (ty >> 1)) * 64 + lane) * 8 + 4 * (ty & 1)) * 2;
            f32x4 a = mm16<64>(SL(11), 72, 16 * tx, SL(0), 72, 16 * ty, ld_row4(SL(4), x, y), lane);
            { u32x2 w; w.x = cvt_pk(a[0], a[1]); w.y = cvt_pk(a[2], a[3]); *(u32x2*)(gout + 8192 + coff) = w; }
            f32x4 dg;
#pragma unroll
            for (int j = 0; j < 4; ++j) dg[j] = (x == y + j) ? GL[x] : 0.f;
            a = mm16<64>(SL(5), 72, 16 * tx, SL(0), 72, 16 * ty, dg, lane);
            { u32x2 w; w.x = cvt_pk(a[0], a[1]); w.y = cvt_pk(a[2], a[3]); *(u32x2*)(gout + coff) = w; }
            st_row4(SL(3), x, y, mm16<64>(SL(11), 72, 16 * tx, SL(2), 72, 16 * ty, ld_row4(SL(12), x, y), lane));
            st_row4(SL(8), x, y, mm16<64>(SL(5), 72, 16 * tx, SL(2), 72, 16 * ty, ld_row4(SL(6), x, y), lane)); }
        __syncthreads();
#pragma unroll
        for (int tyi = 0; tyi < 2; ++tyi) { const int ty = ty0 + tyi;
            const size_t hoff = (size_t)((tx * 4 + ty) * 64 + lane) * 8;
            f32x4 a = mm16<64>(SL(7), 72, 16 * tx, SL(3), 72, 16 * ty, zero, lane);
            { u32x2 w; w.x = cvt_pk(a[0], a[1]); w.y = cvt_pk(a[2], a[3]); *(u32x2*)(gout + 24576 + hoff) = w; }
            a = mm16<64>(SL(7), 72, 16 * tx, SL(8), 72, 16 * ty, zero, lane);
            { u32x2 w; w.x = cvt_pk(a[0], a[1]); w.y = cvt_pk(a[2], a[3]); *(u32x2*)(gout + 16384 + hoff) = w; } }
        __syncthreads();
    }
}
__device__ __forceinline__ void ph_chain(const Params& P0, int b, int task) {
    const Params P = launder(P0);
    const int lane = opaque_tid() & 63, g = lane >> 4, v = lane & 15;
    const int hd = task >> 2, vb = task & 3, h = hd >> 1, d = hd & 1;
    const unsigned char* base = P.ws + OFF_SCAN + (size_t)hd * 260 * 32768;
    bf16_t* Y = (bf16_t*)(P.ws + OFF_XN) + (size_t)d * MT * 512 + h * 64 + vb * 16 + v;
    bf16x8 Sf[2]; Sf[0] = (bf16x8){0, 0, 0, 0, 0, 0, 0, 0}; Sf[1] = Sf[0];
    bf16x8 gs[4][2], gy[4][2], ngs[4][2], ngy[4][2]; u32x2 hs[4], yl[4], nhs[4], nyl[4];
#define CH_LOAD(GS, GY, HS, YL, n) do { const unsigned char* cb = base + (size_t)(n) * 32768; \
        _Pragma("unroll") for (int t = 0; t < 4; ++t) { _Pragma("unroll") for (int s = 0; s < 2; ++s) { \
            GS[t][s] = *(const bf16x8*)(cb + (size_t)((t * 2 + s) * 64 + lane) * 16); GY[t][s] = *(const bf16x8*)(cb + 8192 + (size_t)((t * 2 + s) * 64 + lane) * 16); } \
            HS[t] = *(const u32x2*)(cb + 16384 + (size_t)((vb * 4 + t) * 64 + lane) * 8); YL[t] = *(const u32x2*)(cb + 24576 + (size_t)((vb * 4 + t) * 64 + lane) * 8); } } while (0)
    CH_LOAD(gs, gy, hs, yl, 0);
#pragma unroll 1
    for (int n = 0; n < 260; ++n) {
        if (n + 1 < 260) CH_LOAD(ngs, ngy, nhs, nyl, n + 1);
        int tok0;
        if (n < 4) tok0 = LAT + b * TC + 64 * (d ? 3 - n : n); else tok0 = b * T + 64 * (d ? 255 - (n - 4) : (n - 4));
        f32x4 ns[4];
#pragma unroll
        for (int t = 0; t < 4; ++t) {
            f32x4 a = {bf2f(hs[t].x & 0xffffu), bf2f(hs[t].x >> 16), bf2f(hs[t].y & 0xffffu), bf2f(hs[t].y >> 16)};
            a = __builtin_amdgcn_mfma_f32_16x16x32_bf16(gs[t][0], Sf[0], a, 0, 0, 0);
            a = __builtin_amdgcn_mfma_f32_16x16x32_bf16(gs[t][1], Sf[1], a, 0, 0, 0);
            ns[t] = a;
            f32x4 y = {bf2f(yl[t].x & 0xffffu), bf2f(yl[t].x >> 16), bf2f(yl[t].y & 0xffffu), bf2f(yl[t].y >> 16)};
            y = __builtin_amdgcn_mfma_f32_16x16x32_bf16(gy[t][0], Sf[0], y, 0, 0, 0);
            y = __builtin_amdgcn_mfma_f32_16x16x32_bf16(gy[t][1], Sf[1], y, 0, 0, 0);
#pragma unroll
            for (int j = 0; j < 4; ++j) { const int pos = 16 * t + 4 * g + j, tok = tok0 + (d ? 63 - pos : pos); Y[(size_t)tok * 512] = f2bf(y[j]); }
        }
        { u32x4 w0, w1;
          w0.x = cvt_pk(ns[0][0], ns[0][1]); w0.y = cvt_pk(ns[0][2], ns[0][3]); w0.z = cvt_pk(ns[1][0], ns[1][1]); w0.w = cvt_pk(ns[1][2], ns[1][3]);
          w1.x = cvt_pk(ns[2][0], ns[2][1]); w1.y = cvt_pk(ns[2][2], ns[2][3]); w1.z = cvt_pk(ns[3][0], ns[3][1]); w1.w = cvt_pk(ns[3][2], ns[3][3]);
          Sf[0] = __builtin_bit_cast(bf16x8, w0); Sf[1] = __builtin_bit_cast(bf16x8, w1); }
#pragma unroll
        for (int t = 0; t < 4; ++t) { gs[t][0] = ngs[t][0]; gs[t][1] = ngs[t][1]; gy[t][0] = ngy[t][0]; gy[t][1] = ngy[t][1]; hs[t] = nhs[t]; yl[t] = nyl[t]; }
    }
#undef CH_LOAD
}
__device__ __forceinline__ void ph_pool_task(const Params& P0, int task, unsigned char* smem) {
    const Params P = launder(P0);
    const int tid = opaque_tid();
    const bf16_t* p = (const bf16_t*)(P.ws + OFF_P); bf16_t* mix = (bf16_t*)(P.ws + OFF_MIX);
    if (task < 512) {
        const int b = task >> 8, rr = task & 255, x = tid >> 3, cq = tid & 7;
        float* vs = (float*)smem;
#pragma unroll
        for (int gi = 0; gi < 4; ++gi) { const int half = 1 << gi, c = gi * 64 + cq * 8; const int rlo = max(rr - half, 0), rhi = min(rr + half, 256);
            float a[8] = {0.f, 0.f, 0.f, 0.f, 0.f, 0.f, 0.f, 0.f};
            for (int r2 = rlo; r2 < rhi; ++r2) { float xf[8]; unpack8(*(const bf16x8*)(p + (size_t)(b * T + r2 * 64 + x) * INC + 1792 + c), xf);
#pragma unroll
                for (int j = 0; j < 8; ++j) a[j] += xf[j]; }
            *(f32x4*)(vs + x * 260 + c) = (f32x4){a[0], a[1], a[2], a[3]}; *(f32x4*)(vs + x * 260 + c + 4) = (f32x4){a[4], a[5], a[6], a[7]}; }
        __syncthreads();
#pragma unroll
        for (int gi = 0; gi < 4; ++gi) { const int half = 1 << gi, c = gi * 64 + cq * 8; const int rlo = max(rr - half, 0), rhi = min(rr + half, 256), clo = max(x - half, 0), chi = min(x + half, 64);
            float a[8] = {0.f, 0.f, 0.f, 0.f, 0.f, 0.f, 0.f, 0.f};
            for (int x2 = clo; x2 < chi; ++x2) { const f32x4 v0 = *(const f32x4*)(vs + x2 * 260 + c), v1 = *(const f32x4*)(vs + x2 * 260 + c + 4);
#pragma unroll
                for (int j = 0; j < 4; ++j) { a[j] += v0[j]; a[4 + j] += v1[j]; } }
            const float icnt = 1.0f / (float)((rhi - rlo) * (chi - clo)); const size_t tok = (size_t)b * T + rr * 64 + x;
            float self[8]; unpack8(*(const bf16x8*)(p + tok * INC + 1792 + c), self);
#pragma unroll
            for (int j = 0; j < 8; ++j) a[j] = a[j] * icnt - self[j];
            *(bf16x8*)(mix + tok * MIXK + 512 + c) = pack8(a); }
        __syncthreads();
    } else {
        const int b = task - 512;
        for (int it = tid; it < 256 * 32; it += NT) { const int t = it >> 5, c = (it & 31) * 8, half = 1 << (c >> 6); const int lo = max(t - half, 0), hi = min(t + half, 256);
            float a[8] = {0.f, 0.f, 0.f, 0.f, 0.f, 0.f, 0.f, 0.f};
            for (int t2 = lo; t2 < hi; ++t2) { float xf[8]; unpack8(*(const bf16x8*)(p + (size_t)(LAT + b * TC + t2) * INC + 1792 + c), xf);
#pragma unroll
                for (int j = 0; j < 8; ++j) a[j] += xf[j]; }
            const float icnt = 1.0f / (float)(hi - lo); const size_t tok = (size_t)LAT + b * TC + t;
            float self[8]; unpack8(*(const bf16x8*)(p + tok * INC + 1792 + c), self);
#pragma unroll
            for (int j = 0; j < 8; ++j) a[j] = a[j] * icnt - self[j];
            *(bf16x8*)(mix + tok * MIXK + 512 + c) = pack8(a); }
    }
}
template <int K>
__device__ __forceinline__ void dft_task(const bf16_t* Xmat, const bf16_t* src, size_t sstride, unsigned char* smem, int mode, int b, int idx, bf16_t* Y1, bf16_t* mix) {
    constexpr int ldu = K + 8;
    const int tid = opaque_tid(), lane = tid & 63, wid = tid >> 6, r = lane & 15, g = lane >> 4;
    for (int it = tid; it < K * 32; it += NT) { const int kk = it >> 5, c0 = (it & 31) * 8;
        const bf16x8 v = *(const bf16x8*)(src + (size_t)kk * sstride + c0);
#pragma unroll
        for (int j = 0; j < 8; ++j) *(bf16_t*)(smem + ((size_t)(c0 + j) * ldu + kk) * 2) = (bf16_t)v[j]; }
    bf16x8 xf[2][K / 32];
#pragma unroll
    for (int mt = 0; mt < 2; ++mt)
#pragma unroll
        for (int ks = 0; ks < K / 32; ++ks) xf[mt][ks] = *(const bf16x8*)(Xmat + (size_t)(16 * (2 * wid + mt) + r) * K + 32 * ks + 8 * g);
    __syncthreads();
    for (int ct = 0; ct < 16; ++ct) {
        f32x4 acc[2] = {{0.f, 0.f, 0.f, 0.f}, {0.f, 0.f, 0.f, 0.f}};
#pragma unroll
        for (int ks = 0; ks < K / 32; ++ks) { const bf16x8 yf = *(const bf16x8*)(smem + ((size_t)(16 * ct + r) * ldu + 32 * ks + 8 * g) * 2);
            acc[0] = __builtin_amdgcn_mfma_f32_16x16x32_bf16(yf, xf[0][ks], acc[0], 0, 0, 0); acc[1] = __builtin_amdgcn_mfma_f32_16x16x32_bf16(yf, xf[1][ks], acc[1], 0, 0, 0); }
#pragma unroll
        for (int mt = 0; mt < 2; ++mt) { const int m = 16 * (2 * wid + mt) + r, c = 16 * ct + 4 * g;
            u32x2 w; w.x = cvt_pk(acc[mt][0], acc[mt][1]); w.y = cvt_pk(acc[mt][2], acc[mt][3]);
            if (mode == 0) { const int reim = m >> 7, k1 = m & 127; *(u32x2*)(Y1 + ((size_t)(((b * 128 + k1) * 2 + reim) * 128 + idx)) * 256 + c) = w; }
            else { int reim, tok; if (mode == 1) { reim = m >> 7; tok = b * T + idx + 128 * (m & 127); } else { const int m2 = idx * 256 + m; reim = m2 >> 8; tok = LAT + b * TC + (m2 & 255); }
                *(u32x2*)(mix + (size_t)tok * MIXK + 768 + (c >> 6) * 128 + reim * 64 + (c & 63)) = w; } }
    }
    __syncthreads();
}
__device__ __forceinline__ void ph_readout(const Params& P0, int l, unsigned char* smem, int bid, int nblk) {
    const Params P = launder(P0);
    const int tid = opaque_tid(), lane = tid & 63, h = tid >> 6, r = lane & 15, g = lane >> 4;
    const bf16_t* p = (const bf16_t*)(P.ws + OFF_P); bf16_t* mix = (bf16_t*)(P.ws + OFF_MIX);
    const bf16_t* Yb = (const bf16_t*)(P.ws + OFF_XN); const float* bonus = (const float*)(P.ws + OFF_BONUS);
    const float* sw = P.in[9] + (size_t)l * 3 * 1792;
    const bf16_t* gupT = (const bf16_t*)(P.ws + OFF_GUPT) + (size_t)l * 512 * 128;
    const int ntile = (l == 0) ? MT / 64 : LAT / 64;
    for (int tile = bid; tile < ntile; tile += nblk) {
        const int tok0 = tile * 64;
        int lo, hi; if (tok0 < LAT) { lo = (tok0 / T) * T; hi = lo + T; } else { lo = LAT + ((tok0 - LAT) / TC) * TC; hi = lo + TC; }
        { const int t = tid >> 3, c16 = (tid & 7) * 16; float u[8];
#pragma unroll
          for (int q = 0; q < 2; ++q) { conv8(p, sw, tok0 + t, lo, hi, 1664 + c16 + 8 * q, u);
#pragma unroll
            for (int j = 0; j < 8; ++j) u[j] = sigmoidf_(u[j]);
            *(bf16x8*)(smem + ((size_t)t * 136 + c16 + 8 * q) * 2) = pack8(u); } }
        __syncthreads();
        for (int tx = 0; tx < 4; ++tx) {
            const int t = 16 * tx + r, tok = tok0 + t;
            f32x4 gt[4], ys[4];
            float s1 = 0.f;
#pragma unroll
            for (int cy = 0; cy < 4; ++cy) { f32x4 a = {0.f, 0.f, 0.f, 0.f};
#pragma unroll
                for (int k0 = 0; k0 < 128; k0 += 32) { const bf16x8 xfr = *(const bf16x8*)(smem + ((size_t)t * 136 + k0 + 8 * g) * 2);
                    const bf16x8 yfr = *(const bf16x8*)(gupT + (size_t)(h * 64 + 16 * cy + r) * 128 + k0 + 8 * g);
                    a = __builtin_amdgcn_mfma_f32_16x16x32_bf16(yfr, xfr, a, 0, 0, 0); }
                gt[cy] = a;
                const int hc = h * 64 + 16 * cy + 4 * g;
                const u32x2 y0 = *(const u32x2*)(Yb + (size_t)tok * 512 + hc), y1 = *(const u32x2*)(Yb + ((size_t)MT + tok) * 512 + hc);
                ys[cy] = (f32x4){bf2f(y0.x & 0xffffu) + bf2f(y1.x & 0xffffu), bf2f(y0.x >> 16) + bf2f(y1.x >> 16), bf2f(y0.y & 0xffffu) + bf2f(y1.y & 0xffffu), bf2f(y0.y >> 16) + bf2f(y1.y >> 16)};
                s1 += (ys[cy][0] + ys[cy][1]) + (ys[cy][2] + ys[cy][3]); }
            s1 += __shfl_xor(s1, 16); s1 += __shfl_xor(s1, 32);
            const float mu = s1 * (1.0f / 64.0f); float s2 = 0.f;
#pragma unroll
            for (int cy = 0; cy < 4; ++cy)
#pragma unroll
                for (int j = 0; j < 4; ++j) { const float dd = ys[cy][j] - mu; s2 += dd * dd; }
            s2 += __shfl_xor(s2, 16); s2 += __shfl_xor(s2, 32);
            const float rstd = rsqrtf(s2 * (1.0f / 64.0f) + 64e-5f);
            const float bon = bonus[(size_t)tok * 8 + h] + bonus[((size_t)MT + tok) * 8 + h];
#pragma unroll
            for (int cy = 0; cy < 4; ++cy) { const int hc = h * 64 + 16 * cy + 4 * g;
                const f32x4 vv = conv4(p, sw, tok, lo, hi, 1024 + hc);
                const f32x4 lg = *(const f32x4*)(P.in[18] + l * 512 + hc), lb = *(const f32x4*)(P.in[19] + l * 512 + hc);
                f32x4 o;
#pragma unroll
                for (int j = 0; j < 4; ++j) o[j] = ((ys[cy][j] - mu) * rstd * lg[j] + lb[j] + bon * vv[j]) * gt[cy][j];
                u32x2 w; w.x = cvt_pk(o[0], o[1]); w.y = cvt_pk(o[2], o[3]); *(u32x2*)(mix + (size_t)tok * MIXK + hc) = w; }
        }
        __syncthreads();
    }
}
__device__ __forceinline__ void ph_norm2(const Params& P0, int l, unsigned char* smem, int bid, int nblk) {
    const Params P = launder(P0);
    const int tid = opaque_tid(), lane = tid & 63, gw = bid * 8 + (tid >> 6), ngw = nblk * 8;
    float* RW = (float*)smem;
    for (int i = tid; i < 4096; i += NT) *(f32x4*)(RW + 4 * i) = *(const f32x4*)(P.in[24] + (size_t)l * 16384 + 4 * i);
    __syncthreads();
    const float* mods = (const float*)(P.ws + OFF_MODS); const float* hctx = (const float*)(P.ws + OFF_HCTX);
    bf16_t* h2 = (bf16_t*)(P.ws + OFF_XN); float* aff = (float*)(P.ws + OFF_AFF); float* affc = (float*)(P.ws + OFF_AFFC);
    const float* gn = P.in[7] + l * D;
    const int nrows = (l == 0) ? MT : LAT;
    for (int rr = gw; rr < nrows; rr += ngw) {
        const int s = (rr < LAT) ? rr / T : 2;
        const float* hrow = (rr < LAT) ? P.out + (size_t)rr * D : hctx + (size_t)(rr - LAT) * D;
        f32x4 v[4]; float ss = 0.f;
#pragma unroll
        for (int i = 0; i < 4; ++i) { v[i] = *(const f32x4*)(hrow + 4 * lane + 256 * i); ss += (v[i][0] * v[i][0] + v[i][1] * v[i][1]) + (v[i][2] * v[i][2] + v[i][3] * v[i][3]); }
        const float rs = rsqrtf(wave_sum(ss) * (1.0f / D) + 1e-6f);
        const float* sh = mods + (size_t)(l * 3 + s) * 6144 + 3072, *sc = sh + 1024;
        float lg[16];
#pragma unroll
        for (int e = 0; e < 16; ++e) lg[e] = 0.f;
#pragma unroll
        for (int i = 0; i < 4; ++i) { const int c = 4 * lane + 256 * i;
            const f32x4 y = v[i] * rs * *(const f32x4*)(gn + c) * (*(const f32x4*)(sc + c) + 1.0f) + *(const f32x4*)(sh + c);
            u32x2 w; w.x = cvt_pk(y[0], y[1]); w.y = cvt_pk(y[2], y[3]); *(u32x2*)(h2 + (size_t)rr * D + c) = w;
#pragma unroll
            for (int j = 0; j < 4; ++j) {
#pragma unroll
                for (int q = 0; q < 4; ++q) { const f32x4 wv = *(const f32x4*)(RW + (c + j) * 16 + 4 * q);
                    lg[4 * q] += y[j] * wv[0]; lg[4 * q + 1] += y[j] * wv[1]; lg[4 * q + 2] += y[j] * wv[2]; lg[4 * q + 3] += y[j] * wv[3]; } } }
        float a8[8], a4[4], a2[2], a1;
        { const bool up = (lane & 32) != 0;
#pragma unroll
          for (int k = 0; k < 8; ++k) { const float keep = up ? lg[8 + k] : lg[k], send = up ? lg[k] : lg[8 + k]; a8[k] = keep + __shfl_xor(send, 32); } }
        { const bool up = (lane & 16) != 0;
#pragma unroll
          for (int k = 0; k < 4; ++k) { const float keep = up ? a8[4 + k] : a8[k], send = up ? a8[k] : a8[4 + k]; a4[k] = keep + __shfl_xor(send, 16); } }
        { const bool up = (lane & 8) != 0;
#pragma unroll
          for (int k = 0; k < 2; ++k) { const float keep = up ? a4[2 + k] : a4[k], send = up ? a4[k] : a4[2 + k]; a2[k] = keep + __shfl_xor(send, 8); } }
        { const bool up = (lane & 4) != 0; const float keep = up ? a2[1] : a2[0], send = up ? a2[0] : a2[1]; a1 = keep + __shfl_xor(send, 4); }
        a1 += __shfl_xor(a1, 1); a1 += __shfl_xor(a1, 2);
        float mx = a1;
        mx = fmaxf(mx, __shfl_xor(mx, 4)); mx = fmaxf(mx, __shfl_xor(mx, 8)); mx = fmaxf(mx, __shfl_xor(mx, 16)); mx = fmaxf(mx, __shfl_xor(mx, 32));
        const float ex = __expf(a1 - mx); float sm = ex;
        sm += __shfl_xor(sm, 4); sm += __shfl_xor(sm, 8); sm += __shfl_xor(sm, 16); sm += __shfl_xor(sm, 32);
        if ((lane & 3) == 0) { const int e = ((lane >> 5) & 1) * 8 + ((lane >> 4) & 1) * 4 + ((lane >> 3) & 1) * 2 + ((lane >> 2) & 1); const float a = ex / sm;
            if (rr < LAT) aff[(size_t)((rr / T) * 16 + e) * T + (rr % T)] = a; else affc[(size_t)(((rr - LAT) / TC) * 16 + e) * TC + ((rr - LAT) % TC)] = a; }
    }
    __syncthreads();
}
__device__ __forceinline__ void ph_topk_task(const Params& P0, int pid, unsigned char* smem) {
    const Params P = launder(P0);
    const int tid = opaque_tid(), lane = tid & 63, wid = tid >> 6;
    int* idx = (int*)(P.ws + OFF_IDX); float* gate = (float*)(P.ws + OFF_GATE); int* inv = (int*)(P.ws + OFF_INV);
    unsigned* hist = (unsigned*)smem;
    unsigned* sh = (unsigned*)(smem + 1024);
    if (pid < 32) {
        const int b = pid >> 4, e = pid & 15;
        const float* a = (const float*)(P.ws + OFF_AFF) + (size_t)pid * T + tid * 32;
        unsigned key[32];
#pragma unroll
        for (int i = 0; i < 8; ++i) { const f32x4 v = *(const f32x4*)(a + 4 * i); key[4 * i] = __float_as_uint(v[0]); key[4 * i + 1] = __float_as_uint(v[1]); key[4 * i + 2] = __float_as_uint(v[2]); key[4 * i + 3] = __float_as_uint(v[3]); }
        unsigned prefix = 0u, need = CAP;
        for (int pass = 3; pass >= 0; --pass) {
            const int shf = pass * 8;
            if (tid < 256) hist[tid] = 0u;
            __syncthreads();
            const unsigned himask = (pass == 3) ? 0u : (0xffffffffu << (shf + 8));
#pragma unroll
            for (int i = 0; i < 32; ++i) if ((key[i] & himask) == (prefix & himask)) atomicAdd(&hist[(key[i] >> shf) & 255u], 1u);
            __syncthreads();
            if (tid == 0) { unsigned cum = 0u; int bsel = 0;
                for (int bb = 255; bb >= 0; --bb) { const unsigned hb = hist[bb]; if (cum + hb >= need) { bsel = bb; break; } cum += hb; }
                sh[0] = prefix | ((unsigned)bsel << shf); sh[1] = need - cum; }
            __syncthreads();
            prefix = sh[0]; need = sh[1];
            __syncthreads();
        }
        unsigned neq = 0u, ngt = 0u;
#pragma unroll
        for (int i = 0; i < 32; ++i) { neq += (key[i] == prefix); ngt += (key[i] > prefix); }
        unsigned eq_incl = neq;
#pragma unroll
        for (int o = 1; o < 64; o <<= 1) { const unsigned t2 = __shfl_up(eq_incl, o); if (lane >= o) eq_incl += t2; }
        if (lane == 63) sh[8 + wid] = eq_incl;
        __syncthreads();
        unsigned eq_off = eq_incl - neq;
        for (int w2 = 0; w2 < wid; ++w2) eq_off += sh[8 + w2];
        unsigned nsel = ngt, er = eq_off;
#pragma unroll
        for (int i = 0; i < 32; ++i) if (key[i] == prefix) { nsel += (er < need); ++er; }
        unsigned sel_incl = nsel;
#pragma unroll
        for (int o = 1; o < 64; o <<= 1) { const unsigned t2 = __shfl_up(sel_incl, o); if (lane >= o) sel_incl += t2; }
        if (lane == 63) sh[16 + wid] = sel_incl;
        __syncthreads();
        unsigned slot = sel_incl - nsel;
        for (int w2 = 0; w2 < wid; ++w2) slot += sh[16 + w2];
        er = eq_off;
#pragma unroll
        for (int i = 0; i < 32; ++i) { const int t = tid * 32 + i; bool s = key[i] > prefix;
            if (key[i] == prefix) { s = (er < need); ++er; }
            const int tok = b * T + t;
            if (s) { idx[(size_t)pid * CAP + slot] = tok; gate[(size_t)pid * CAP + slot] = __uint_as_float(key[i]); inv[(size_t)tok * 16 + e] = (int)slot; ++slot; }
            else inv[(size_t)tok * 16 + e] = -1; }
        __syncthreads();
    } else {
        const int gidx = pid - 32, b = gidx >> 4, e = gidx & 15;
        float* vals = (float*)(smem + 2048);
        const float* a = (const float*)(P.ws + OFF_AFFC) + (size_t)gidx * TC;
        if (tid < 256) vals[tid] = a[tid];
        __syncthreads();
        if (tid < 256) { const float mv = vals[tid]; int rank = 0;
            for (int j = 0; j < 256; ++j) { const float o = vals[j]; rank += (o > mv) || (o == mv && j < tid); }
            const int tok = LAT + b * TC + tid;
            if (rank < CAPC) { idx[65536 + (size_t)gidx * 256 + rank] = tok; gate[65536 + (size_t)gidx * 256 + rank] = mv; inv[(size_t)tok * 16 + e] = rank; }
            else inv[(size_t)tok * 16 + e] = -1; }
        __syncthreads();
    }
}
__device__ __forceinline__ void ph_convw(const Params& P0, int l, unsigned char* smem, int vb, int nvb) {
    const Params P = launder(P0);
    for (int t = vb; t < 48 * 256; t += nvb) { const int mat = t >> 8, r = t & 255, tk = r >> 4, tn = r & 15, kind = mat >> 4, e = mat & 15;
        const float* src = (kind == 0 ? P.in[25] : (kind == 1 ? P.in[26] : P.in[27])) + (size_t)(l * 16 + e) * D * D;
        bf16_t* dst = (kind < 2) ? (bf16_t*)(P.ws + OFF_WGU) + (size_t)e * 2048 * D : (bf16_t*)(P.ws + OFF_WD) + (size_t)e * D * D;
        transpose_tile(src, D, dst, D, kind == 0 ? 1 : (kind == 1 ? 2 : 0), tk, tn, smem); }
}
__device__ __forceinline__ void ph_gather(const Params& P0, int l, int bid, int nblk) {
    const Params P = launder(P0);
    const int lane = opaque_tid() & 63, gw = bid * 8 + (opaque_tid() >> 6), ngw = nblk * 8;
    const int* idx = (const int*)(P.ws + OFF_IDX); const bf16_t* h2 = (const bf16_t*)(P.ws + OFF_XN); bf16_t* xe = (bf16_t*)(P.ws + OFF_XE);
    const int nrow = 65536 + ((l == 0) ? 32 * 32 : 0);
    for (int i = gw; i < nrow; i += ngw) {
        const int row = (i < 65536) ? i : 65536 + ((i - 65536) >> 5) * 256 + ((i - 65536) & 31);
        const int tok = idx[row];
        const u32x4 a = *(const u32x4*)(h2 + (size_t)tok * D + lane * 8), c = *(const u32x4*)(h2 + (size_t)tok * D + 512 + lane * 8);
        *(u32x4*)(xe + (size_t)row * D + lane * 8) = a; *(u32x4*)(xe + (size_t)row * D + 512 + lane * 8) = c;
    }
}

__global__ void __launch_bounds__(NT, 2) hybrid_fwd(Params PK) {
    extern __shared__ __attribute__((aligned(16))) unsigned char smem[];
    const int tid = opaque_tid(), G = gridDim.x, bid = blockIdx.x;
    LAS unsigned char* lds = (LAS unsigned char*)smem;
    if (tid < 64) ((volatile LAS unsigned*)(lds + LDS_MISC))[tid] = 0u;
    __syncthreads();
    XcdBarrier bar = xcd_barrier_post((unsigned*)(PK.ws + OFF_CTL), (volatile LAS unsigned*)(lds + LDS_MISC));
#ifndef STOP_AFTER
#define STOP_AFTER 0
#endif
#ifndef DUMP_OFF
#define DUMP_OFF 0
#define DUMP_WORDS 0
#endif
    int nsync = 0;
#define GRID_SYNC() do { unsigned* bp_ = (unsigned*)(PK.ws + OFF_CTL); asm volatile("" : "+s"(bp_)); bar.bar = bp_; xcd_barrier(bar); if (STOP_AFTER > 0 && ++nsync >= STOP_AFTER) { if (DUMP_OFF) { const unsigned* srcw = (const unsigned*)(PK.ws + (size_t)DUMP_OFF); for (size_t i = (size_t)bid * NT + tid; i < (size_t)DUMP_WORDS; i += (size_t)G * NT) PK.out[i] = (float)(srcw[i] & 0xffffffu); } return; } } while (0)

    if (EN(0)) { ph_mods(PK, smem, bid, G);
    ph_prep_weights(PK, smem, bid, G);
    ph_tables(PK, bid, G); }
    GRID_SYNC();
    if (EN(1)) { ph_fold(PK, bid, G);
    ph_norm1(PK, 0, bid, G); }
    GRID_SYNC();

#pragma unroll 1
    for (int l = 0; l < 2; ++l) {
        if (EN(1)) if (l > 0) { ph_norm1(PK, 1, bid, G); GRID_SYNC(); }
        if (EN(2)) { const Params P = launder(PK); pg8::SchedDense S; S.init(MT, INC, D, G, bid, P.ws + OFF_XN, P.ws + OFF_WINT + (size_t)l * INC * D * 2);
          pg8::EpiBf16Plain E{(bf16_t*)(P.ws + OFF_P), INC};
          pg8::gemm_phase<pg8::EpiBf16Plain, pg8::SchedDense>(lds, D, S, E); }
        GRID_SYNC();
        if (EN(3)) ph_sa(PK, l, 0, smem, bid, G);
        GRID_SYNC();
        if (bid < 64) { if (EN(4)) if (tid < 64) ph_chain(PK, 0, bid); }
        else if (EN(5)) { const Params P = launder(PK);
            const int vb = bid - 64, nvb = G - 64;
            for (int task = vb; task < 256; task += nvb) { const int b = task >> 7, t2 = task & 127;
                dft_task<128>((const bf16_t*)(P.ws + OFF_D1), (const bf16_t*)(P.ws + OFF_P) + (size_t)(b * T + t2) * INC + 2048, (size_t)128 * INC, smem, 0, b, t2, (bf16_t*)(P.ws + OFF_Y1), (bf16_t*)(P.ws + OFF_MIX)); }
            const int npool = (l == 0) ? 514 : 512;
            for (int task = vb; task < npool; task += nvb) ph_pool_task(PK, task, smem);
        }
        GRID_SYNC();
        if (EN(3)) ph_sa(PK, l, 1, smem, bid, G);
        GRID_SYNC();
        if (bid < 64) { if (EN(4)) if (tid < 64) ph_chain(PK, 1, bid); }
        else if (EN(6)) { const Params P = launder(PK);
            const int vb = bid - 64, nvb = G - 64;
            for (int task = vb; task < 256; task += nvb) { const int b = task >> 7, k1 = task & 127;
                dft_task<256>((const bf16_t*)(P.ws + OFF_E2) + (size_t)k1 * 65536, (const bf16_t*)(P.ws + OFF_Y1) + (size_t)(b * 128 + k1) * 65536, 256, smem, 1, b, k1, (bf16_t*)(P.ws + OFF_Y1), (bf16_t*)(P.ws + OFF_MIX)); }
            if (l == 0) for (int task = vb; task < 4; task += nvb) { const int b = task >> 1, half = task & 1;
                dft_task<256>((const bf16_t*)(P.ws + OFF_DCTX) + (size_t)half * 65536, (const bf16_t*)(P.ws + OFF_P) + (size_t)(LAT + b * TC) * INC + 2048, INC, smem, 2, b, half, (bf16_t*)(P.ws + OFF_Y1), (bf16_t*)(P.ws + OFF_MIX)); }
        }
        GRID_SYNC();
        if (EN(7)) ph_readout(PK, l, smem, bid, G);
        GRID_SYNC();
        if (EN(8)) { const Params P = launder(PK); pg8::SchedDense S; S.init((l == 0) ? MT : LAT, D, MIXK, G, bid, P.ws + OFF_MIX, P.ws + OFF_WOT + (size_t)l * D * MIXK * 2);
          pg8::EpiResid E{P.out, (float*)(P.ws + OFF_HCTX), (const float*)(P.ws + OFF_MODS) + (size_t)l * 3 * 6144};
          pg8::gemm_phase<pg8::EpiResid, pg8::SchedDense>(lds, MIXK, S, E); }
        GRID_SYNC();
        if (EN(9)) ph_norm2(PK, l, smem, bid, G);
        GRID_SYNC();
        if (bid < 64) { if (EN(10)) if (bid < 32 || l == 0) ph_topk_task(PK, bid, smem); }
        else if (EN(11)) ph_convw(PK, l, smem, bid - 64, G - 64);
        GRID_SYNC();
        if (EN(11)) ph_gather(PK, l, bid, G);
        GRID_SYNC();
        if (EN(12)) { const Params P = launder(PK); pg8::SchedMoe1 S{bid, l == 0, (const char*)(P.ws + OFF_XE), (const char*)(P.ws + OFF_WGU), (size_t)256 * D * 2};
          pg8::EpiSwiglu E{(bf16_t*)(P.ws + OFF_HID)};
          pg8::gemm_phase<pg8::EpiSwiglu, pg8::SchedMoe1>(lds, D, S, E); }
        GRID_SYNC();
        if (EN(13)) { const Params P = launder(PK); pg8::SchedMoe2 S{bid, l == 0, (const char*)(P.ws + OFF_HID), (const char*)(P.ws + OFF_WD), (size_t)256 * D * 2};
          pg8::EpiScaleRow E{(bf16_t*)(P.ws + OFF_XE), (const float*)(P.ws + OFF_GATE)};
          pg8::gemm_phase<pg8::EpiScaleRow, pg8::SchedMoe2>(lds, D, S, E); }
        GRID_SYNC();
    }
    if (EN(1)) ph_norm1(PK, 2, bid, G);
}

extern "C" void kernel_launch(void* const* d_in, const int* in_sizes, int n_in, void* d_out, int out_size, void* d_ws, size_t ws_size, hipStream_t stream) {
    static int grid = 0;
    if (grid == 0) {
        if (n_in != 29 || out_size != LAT * D || ws_size < WS_NEED) { fprintf(stderr, "kernel_launch: unexpected shapes (n_in %d, out %d, ws %zu < %zu)\n", n_in, out_size, ws_size, (size_t)WS_NEED); grid = -1; return; }
        int dev = 0, cus = 0;
        if (hipGetDevice(&dev) != hipSuccess || hipDeviceGetAttribute(&cus, hipDeviceAttributeMultiprocessorCount, dev) != hipSuccess) { grid = -1; return; }
        if (hipFuncSetAttribute((const void*)hybrid_fwd, hipFuncAttributeMaxDynamicSharedMemorySize, LDS_BYTES) != hipSuccess) { fprintf(stderr, "kernel_launch: hipFuncSetAttribute failed\n"); grid = -1; return; }
        (void)hipGetLastError();
        grid = cus;
    }
    if (grid < 0) return;
    if (hipMemsetAsync((char*)d_ws + OFF_CTL, 0, 16384, stream) != hipSuccess) return;
    Params p{};
    for (int i = 0; i < 29; ++i) p.in[i] = (const float*)d_in[i];
    p.out = (float*)d_out; p.ws = (unsigned char*)d_ws;
    hipLaunchKernelGGL(hybrid_fwd, dim3(grid), dim3(NT), LDS_BYTES, stream, p);
}
```

```cpp
#include <hip/hip_runtime.h>
#include <cstdio>
#include <cstdint>
#include <cmath>

#define LAS __attribute__((address_space(3)))
typedef unsigned short bf16_t;
typedef short bf16x8 __attribute__((ext_vector_type(8)));
typedef float f32x4 __attribute__((ext_vector_type(4)));
typedef float f32x2 __attribute__((ext_vector_type(2)));
typedef unsigned u32x4 __attribute__((ext_vector_type(4)));
typedef unsigned u32x2 __attribute__((ext_vector_type(2)));

constexpr int NB = 2, T = 16384, TC = 256, D = 1024;
constexpr int LAT = NB * T, MT = LAT + NB * TC;
constexpr int INC = 2304, MIXK = 1280;
constexpr int CAP = 2048, CAPC = 32;
constexpr int XE_ROWS = 65536 + 32 * 256;
constexpr int NT = 512;
constexpr int SA_EARLY = 288;
constexpr int NPREP = 96;

constexpr size_t OFF_CTL   = 0;
constexpr size_t OFF_MODS  = 16384;
constexpr size_t OFF_WINT  = OFF_MODS + 147456;
constexpr size_t OFF_WOT   = OFF_WINT + 9437184;
constexpr size_t OFF_DUPT  = OFF_WOT + 5242880;
constexpr size_t OFF_IUPT  = OFF_DUPT + 262144;
constexpr size_t OFF_GUPT  = OFF_IUPT + 262144;
constexpr size_t OFF_WCS   = OFF_GUPT + 262144;
constexpr size_t OFF_D1    = OFF_WCS + 262144;
constexpr size_t OFF_DCTX  = OFF_D1 + 65536;
constexpr size_t OFF_E2    = OFF_DCTX + 262144;
constexpr size_t OFF_HCTX  = OFF_E2 + 16777216;
constexpr size_t OFF_AFF   = OFF_HCTX + 2097152;
constexpr size_t OFF_AFFC  = OFF_AFF + 2097152;
constexpr size_t OFF_IDX   = OFF_AFFC + 32768;
constexpr size_t OFF_GATE  = OFF_IDX + 294912;
constexpr size_t OFF_INV   = OFF_GATE + 294912;
constexpr size_t OFF_BONUS = OFF_INV + 2129920;
constexpr size_t OFF_XN    = OFF_BONUS + 2129920;
constexpr size_t OFF_BIG   = OFF_XN + 68157440;
constexpr size_t OFF_P     = OFF_BIG;
constexpr size_t OFF_MIX   = OFF_P + 153354240;
constexpr size_t OFF_GH    = OFF_MIX + 85196800;
constexpr size_t OFF_GY    = OFF_GH + 68157440;
constexpr size_t OFF_Y1    = OFF_GY + 136314880;
constexpr size_t OFF_SLAB  = OFF_Y1 + 33554432;
constexpr size_t OFF_GH2   = OFF_SLAB;
constexpr size_t END_MIXV  = OFF_SLAB + 17039360;
constexpr size_t OFF_WGU   = OFF_BIG;
constexpr size_t OFF_WD    = OFF_WGU + 67108864;
constexpr size_t OFF_XE    = OFF_WD + 33554432;
constexpr size_t OFF_HID   = OFF_XE + 150994944;
constexpr size_t END_MOEV  = OFF_HID + 150994944;
constexpr size_t WS_NEED   = END_MIXV > END_MOEV ? END_MIXV : END_MOEV;

constexpr int SLOT = 8192;
constexpr int LDS_LW   = 14 * SLOT;
constexpr int LDS_SEG  = LDS_LW + 64 * 68 * 4;
constexpr int LDS_GL   = LDS_SEG + 16 * 64 * 4;
constexpr int LDS_BON  = LDS_GL + 256;
constexpr int LDS_MISC = 148992;
static_assert(LDS_BON + 256 <= LDS_MISC, "LDS map");
constexpr int LDS_MISC_UNUSED = LDS_BON + 256;
constexpr int LDS_BYTES = LDS_MISC + 256;

#ifndef PROF_SA
#define PROF_SA 0
#endif
#ifndef PROF_A
#define PROF_BINS 4.0f
#define PROF_A -1
#define PROF_B -1
#define PROF_A0 (PROF_A - 1)
#define PROF_B0 (PROF_B - 1)
#define PROF_UNIT 10.0f
#endif
#ifndef DUMP_OFF
#define DUMP_OFF 0
#define DUMP_WORDS 0
#endif
#ifndef STOP_AFTER
#define STOP_AFTER 0
#endif
#ifndef PHMASK
#define PHMASK 0xffffffffu
#endif
#define EN(n) (((PHMASK) >> (n)) & 1u)
struct Params { const float* in[29]; float* out; unsigned char* ws; };


__device__ __forceinline__ int opaque_tid() { int t = threadIdx.x; asm volatile("" : "+v"(t)); return t; }
__device__ __forceinline__ Params launder(const Params& P0) {
    typedef const __attribute__((address_space(4))) Params* kparams_t;
    kparams_t kp = (kparams_t)__builtin_amdgcn_kernarg_segment_ptr();
    asm volatile("" : "+s"(kp));
    (void)P0;
    Params Q;
#pragma unroll
    for (int i = 0; i < 29; ++i) Q.in[i] = (const float*)(const __attribute__((address_space(1))) float*)kp->in[i];
    Q.out = (float*)(__attribute__((address_space(1))) float*)kp->out; Q.ws = (unsigned char*)(__attribute__((address_space(1))) unsigned char*)kp->ws;
    return Q;
}
__device__ __forceinline__ float bf2f(unsigned b) { return __uint_as_float(b << 16); }
template <typename T> __device__ __forceinline__ T ldo(const void* base, unsigned byteoff) { return *(const T*)((const char*)base + byteoff); }
typedef __bf16 bf16v2_t __attribute__((ext_vector_type(2)));
typedef float f32v2_t __attribute__((ext_vector_type(2)));
__device__ __forceinline__ unsigned cvt_pk(float lo, float hi) { const f32v2_t v = {lo, hi}; const bf16v2_t b = __builtin_convertvector(v, bf16v2_t); return __builtin_bit_cast(unsigned, b); }
__device__ __forceinline__ bf16_t f2bf(float f) { return (bf16_t)(cvt_pk(f, 0.f) & 0xffffu); }
template <int M> __device__ __forceinline__ float sx(float x, int lane) {
    if constexpr (M < 32) return __int_as_float(__builtin_amdgcn_ds_swizzle(__float_as_int(x), (M << 10) | 0x1F));
    else return __int_as_float(__builtin_amdgcn_ds_bpermute((lane ^ M) << 2, __float_as_int(x)));
}
__device__ __forceinline__ float wave_sum(float v, int lane) {
    v += sx<1>(v, lane); v += sx<2>(v, lane); v += sx<4>(v, lane); v += sx<8>(v, lane); v += sx<16>(v, lane); v += sx<32>(v, lane);
    return v;
}
__device__ __forceinline__ float sigmoidf_(float x) { return __builtin_amdgcn_rcpf(1.0f + __expf(-x)); }

#define XB_TMO      128
#define XB_XCNT(j)  (256  + 64 * (j))
#define XB_XSUB(j)  (1280 + 64 * (j))
#define XB_XGEN(j)  (2304 + 64 * (j))
#define XB_TOP      3328
#define XB_TOPGEN   3392
#define XCD_BAR_WORDS 3456
#define XB_SPIN_CAP (1u << 22)
__device__ __forceinline__ unsigned xb_ld(unsigned* p)              { return __hip_atomic_load(p, __ATOMIC_RELAXED, __HIP_MEMORY_SCOPE_AGENT); }
__device__ __forceinline__ unsigned xb_add(unsigned* p, unsigned v) { return __hip_atomic_fetch_add(p, v, __ATOMIC_RELAXED, __HIP_MEMORY_SCOPE_AGENT); }
__device__ __forceinline__ unsigned xb_xcc_id() { return (unsigned)__builtin_amdgcn_s_getreg((3 << 11) | 20) & 0xFu; }
#define XB_SPIN(cond, bar) do { unsigned _sp = 0; while (cond) { __builtin_amdgcn_s_sleep(1); \
    if ((++_sp & 255u) == 0u) { if (xb_ld(&(bar)[XB_TMO])) break; if (_sp > XB_SPIN_CAP) { atomicAdd(&(bar)[XB_TMO], 1u); break; } } } } while (0)
struct XcdBarrier { unsigned* bar; unsigned x; volatile LAS unsigned* st; };
__device__ __forceinline__ XcdBarrier xcd_barrier_post(unsigned* bar, volatile LAS unsigned* st) {
    XcdBarrier b; b.bar = bar; b.x = xb_xcc_id(); b.st = st;
    if (threadIdx.x == 0) (void)xb_add(&bar[XB_XCNT(b.x)], 1u);
    return b;
}
__device__ __forceinline__ void xcd_barrier_complete(unsigned* bar, unsigned x, unsigned& nloc, unsigned& nx) {
    const unsigned G = gridDim.x * gridDim.y * gridDim.z;
    unsigned sum, cnt, mine, sp = 0u;
    for (;;) {
        sum = 0u; cnt = 0u; mine = 0u;
#pragma unroll
        for (unsigned j = 0; j < 16; ++j) { const unsigned c = xb_ld(&bar[XB_XCNT(j)]); sum += c; cnt += (c > 0u) ? 1u : 0u; mine = (j == x) ? c : mine; }
        if (sum == G) break;
        __builtin_amdgcn_s_sleep(1);
        if ((++sp & 255u) == 0u) { if (xb_ld(&bar[XB_TMO])) break; if (sp > XB_SPIN_CAP) { atomicAdd(&bar[XB_TMO], 1u); break; } }
    }
    nloc = mine > 0u ? mine : 1u; nx = cnt > 0u ? cnt : 1u;
}
__device__ __forceinline__ void xcd_barrier(const XcdBarrier& b) {
    asm volatile("s_waitcnt vmcnt(0)" ::: "memory");
    __syncthreads();
    if (threadIdx.x == 0) {
        unsigned* bar = b.bar;
        __builtin_amdgcn_s_waitcnt(0);
        unsigned nloc = b.st[0], nx = b.st[1];
        if (nloc == 0u) { xcd_barrier_complete(bar, b.x, nloc, nx); b.st[0] = nloc; b.st[1] = nx; }
        const unsigned old = xb_add(&bar[XB_XSUB(b.x)], 1u);
        const unsigned gen = old / nloc;
        if (old + 1u == (gen + 1u) * nloc) {
            __builtin_amdgcn_fence(__ATOMIC_RELEASE, "agent");
            asm volatile("s_waitcnt vmcnt(0)" ::: "memory");
            const unsigned og = xb_add(&bar[XB_TOP], 1u);
            const unsigned tg = og / nx;
            if (og + 1u == (tg + 1u) * nx) xb_add(&bar[XB_TOPGEN], 1u);
            else XB_SPIN(xb_ld(&bar[XB_TOPGEN]) == tg, bar);
            __builtin_amdgcn_fence(__ATOMIC_ACQUIRE, "agent");
            xb_add(&bar[XB_XGEN(b.x)], 1u);
            asm volatile("s_waitcnt vmcnt(0)" ::: "memory");
        } else {
            XB_SPIN(xb_ld(&bar[XB_XGEN(b.x)]) == gen, bar);
            __builtin_amdgcn_fence(__ATOMIC_ACQUIRE, "agent");
            asm volatile("s_waitcnt vmcnt(0)" ::: "memory");
        }
    }
    __syncthreads();
}

namespace pg8 {
constexpr int BM = 256, BK = 64, HALF = 128, HTB = HALF * BK * 2, NXCD = 8, WGM = 8;
__device__ __forceinline__ int lds_byte(int r, int c) { const int st = (r >> 4) * 2 + (c >> 5), rr = r & 15, cc = c & 31, ob = rr * 64 + cc * 2; return st * 1024 + (ob ^ (((ob >> 9) & 1) << 5)); }
__device__ __forceinline__ void stage_rc(int b, int& R, int& C) { const int st = b / 1024, sb = b % 1024, swz = sb ^ (((sb >> 9) & 1) << 5); R = (st >> 1) * 16 + swz / 64; C = (st & 1) * 32 + (swz % 64) / 2; }
__device__ __forceinline__ int perm32(int rho) { const int n = rho >> 4, i = rho & 15; return 8 * (i >> 2) + 4 * n + (i & 3); }
struct Unit { int pm, pn; const char* A; const char* B; int aux; };

template <class Epi, class Sched>
__device__ __forceinline__ void gemm_phase(LAS unsigned char* lds, const int K, const int LDK  , const Sched& S, const Epi& E) {
    const int tid = opaque_tid(), wid = __builtin_amdgcn_readfirstlane(tid >> 6), lane = tid & 63, wr = wid >> 2, wc = wid & 3, fr = lane & 15, fq = lane >> 4;
    const int nt = K / BK;
    unsigned voffA[2], voffB[2];
#pragma unroll
    for (int i = 0; i < 2; ++i) { int R, C; stage_rc(tid * 16 + i * 8192, R, C); const int Rb = Epi::PERM ? ((R & ~31) + perm32(R & 31)) : R;
        voffA[i] = (unsigned)(R * LDK + C) * 2u; voffB[i] = (unsigned)(Rb * LDK + C) * 2u; }
    const LAS int* lidx = (const LAS int*)(lds + 8 * HTB);
    if constexpr (Sched::GATHER) { Unit u_; const int t_ = opaque_tid();
        int iv_[16];
#pragma unroll
        for (int i_ = 0; i_ < 16; ++i_) { iv_[i_] = 0; if (S.next(i_, u_) && t_ < BM) iv_[i_] = S.idx[(size_t)u_.pm * BM + t_]; }
        __builtin_amdgcn_sched_barrier(0);
#pragma unroll
        for (int i_ = 0; i_ < 16; ++i_) if (t_ < BM) ((LAS int*)(lds + 8 * HTB))[i_ * BM + t_] = iv_[i_];
        __syncthreads(); }
    unsigned vgc[2][2] = {{0u, 0u}, {0u, 0u}}, vgn[2][2] = {{0u, 0u}, {0u, 0u}};
#define PG8_GLOAD(vg, unit) do { if constexpr (Sched::GATHER) { _Pragma("unroll") for (int hh_ = 0; hh_ < 2; ++hh_) _Pragma("unroll") for (int i_ = 0; i_ < 2; ++i_) \
        { int R_, C_; stage_rc(opaque_tid() * 16 + i_ * 8192, R_, C_); vg[hh_][i_] = (unsigned)lidx[(unit) * BM + hh_ * HALF + R_] * (unsigned)(LDK * 2) + (unsigned)C_ * 2u; } } } while (0)
#define PG8_STAGE_A(bufoff, base, hh, nx) do { if constexpr (Sched::GATHER) { const unsigned vt_[2] = {(nx) ? vgn[hh][0] : vgc[hh][0], (nx) ? vgn[hh][1] : vgc[hh][1]}; PG8_STAGE(bufoff, base, vt_); } \
        else { PG8_STAGE(bufoff, (base) + (hh) * hstep, voffA); } } while (0)
    const size_t kstep = (size_t)(BK * 2);
    const size_t hstep = (size_t)HALF * LDK * 2;
    const unsigned ldsw = (unsigned)wid * 1024u;
    const int aoff = lds_byte(wr * 64 + fr, fq * 8), boff = lds_byte(wc * 32 + fr, fq * 8);
#define PG8_SA(b, h) (((b) * 2 + (h)) * HTB)
#define PG8_SB(b, h) ((4 + (b) * 2 + (h)) * HTB)
#define PG8_STAGE(bufoff, gbase, voff) do { _Pragma("unroll") for (int _i = 0; _i < 2; ++_i) \
        __builtin_amdgcn_global_load_lds((const unsigned*)((const char*)(gbase) + (voff)[_i]), (LAS unsigned*)(lds + (bufoff) + ldsw + _i * 8192), 16, 0, 0); } while (0)
#define PG8_LDA(dst, b, h) do { _Pragma("unroll") for (int m = 0; m < 4; ++m) _Pragma("unroll") for (int k = 0; k < 2; ++k) dst[m][k] = *(const LAS bf16x8*)(lds + PG8_SA(b, h) + aoff + m * 2048 + k * 1024); } while (0)
#define PG8_LDB(dst, b, h) do { _Pragma("unroll") for (int n = 0; n < 2; ++n) _Pragma("unroll") for (int k = 0; k < 2; ++k) dst[n][k] = *(const LAS bf16x8*)(lds + PG8_SB(b, h) + boff + n * 2048 + k * 1024); } while (0)
#define PG8_MMA(ai, bj, At, Bt) do { __builtin_amdgcn_s_setprio(1); _Pragma("unroll") for (int m = 0; m < 4; ++m) _Pragma("unroll") for (int n = 0; n < 2; ++n) _Pragma("unroll") for (int k = 0; k < 2; ++k) \
        acc[ai][bj][m][n] = __builtin_amdgcn_mfma_f32_16x16x32_bf16(Bt[n][k], At[m][k], acc[ai][bj][m][n], 0, 0, 0); __builtin_amdgcn_s_setprio(0); } while (0)
#define PG8_WAIT_V(n) asm volatile("s_waitcnt vmcnt(" #n ")" ::: "memory")
#define PG8_WAIT_L(n) asm volatile("s_waitcnt lgkmcnt(" #n ")" ::: "memory")
#define PG8_BAR __builtin_amdgcn_s_barrier()
#define PG8_SCHED __builtin_amdgcn_sched_barrier(0)
    Unit cur, nxt; int ui = 0;
    if (!S.next(0, cur)) return;
    f32x4 acc[2][2][4][2];
#pragma unroll
    for (int a = 0; a < 2; ++a)
#pragma unroll
        for (int b = 0; b < 2; ++b)
#pragma unroll
            for (int m = 0; m < 4; ++m)
#pragma unroll
                for (int n = 0; n < 2; ++n) acc[a][b][m][n] = (f32x4){0.f, 0.f, 0.f, 0.f};
    bf16x8 At[4][2], B0[2][2], B1[2][2];
    const char* cA = cur.A; const char* cB = cur.B;
    PG8_GLOAD(vgc, 0);
    PG8_STAGE(PG8_SB(0, 0), cB, voffB); PG8_STAGE_A(PG8_SA(0, 0), cA, 0, false); PG8_STAGE(PG8_SB(0, 1), cB + hstep, voffB); PG8_STAGE_A(PG8_SA(0, 1), cA, 1, false);
    if (wr == 1) PG8_BAR;
    PG8_WAIT_V(4); PG8_BAR;
    PG8_STAGE(PG8_SB(1, 0), cB + kstep, voffB); PG8_STAGE_A(PG8_SA(1, 0), cA + kstep, 0, false); PG8_STAGE(PG8_SB(1, 1), cB + hstep + kstep, voffB);
    PG8_WAIT_V(6); PG8_BAR;
    for (;;) {
        const bool has_next = S.next(ui + 1, nxt);
        const char* nA = has_next ? nxt.A : cA; const char* nB = has_next ? nxt.B : cB;
        if constexpr (Sched::GATHER) { if (has_next) PG8_GLOAD(vgn, ui + 1); else { vgn[0][0] = vgc[0][0]; vgn[0][1] = vgc[0][1]; vgn[1][0] = vgc[1][0]; vgn[1][1] = vgc[1][1]; } }
        for (int t = 0; t < nt; t += 2) {
            const bool last = (t == nt - 2);
            const char* a1 = cA + (size_t)(t + 1) * kstep;
            const char* a2 = last ? nA : cA + (size_t)(t + 2) * kstep; const char* b2 = last ? nB : cB + (size_t)(t + 2) * kstep;
            const char* a3 = a2 + kstep; const char* b3 = b2 + kstep;
            PG8_LDB(B0, 0, 0); PG8_SCHED; PG8_LDA(At, 0, 0); PG8_STAGE_A(PG8_SA(1, 1), a1, 1, false);
            PG8_WAIT_L(8); PG8_BAR; PG8_WAIT_L(0); PG8_MMA(0, 0, At, B0); PG8_BAR; PG8_SCHED;
            PG8_LDB(B1, 0, 1); PG8_STAGE(PG8_SB(0, 0), b2, voffB);
            PG8_BAR; PG8_WAIT_L(0); PG8_MMA(0, 1, At, B1); PG8_BAR;
            PG8_LDA(At, 0, 1); PG8_STAGE_A(PG8_SA(0, 0), a2, 0, last);
            PG8_BAR; PG8_WAIT_L(0); PG8_MMA(1, 0, At, B0); PG8_BAR; PG8_SCHED;
            PG8_STAGE(PG8_SB(0, 1), b2 + hstep, voffB);
            PG8_WAIT_V(6); PG8_BAR; PG8_MMA(1, 1, At, B1); PG8_BAR;
            PG8_LDB(B0, 1, 0); PG8_SCHED; PG8_LDA(At, 1, 0); PG8_STAGE_A(PG8_SA(0, 1), a2, 1, last);
            PG8_WAIT_L(8); PG8_BAR; PG8_WAIT_L(0); PG8_MMA(0, 0, At, B0); PG8_BAR; PG8_SCHED;
            PG8_LDB(B1, 1, 1); PG8_STAGE(PG8_SB(1, 0), b3, voffB);
            PG8_BAR; PG8_WAIT_L(0); PG8_MMA(0, 1, At, B1); PG8_BAR;
            PG8_LDA(At, 1, 1); PG8_STAGE_A(PG8_SA(1, 0), a3, 0, last);
            PG8_BAR; PG8_WAIT_L(0); PG8_MMA(1, 0, At, B0); PG8_BAR; PG8_SCHED;
            PG8_STAGE(PG8_SB(1, 1), b3 + hstep, voffB);
            PG8_WAIT_V(6); PG8_BAR; PG8_MMA(1, 1, At, B1); PG8_BAR;
        }
        E(acc, cur, wr, wc, fr, fq);
        if (!has_next) break;
#pragma unroll
        for (int a = 0; a < 2; ++a)
#pragma unroll
            for (int b = 0; b < 2; ++b)
#pragma unroll
                for (int m = 0; m < 4; ++m)
#pragma unroll
                    for (int n = 0; n < 2; ++n) acc[a][b][m][n] = (f32x4){0.f, 0.f, 0.f, 0.f};
        cur = nxt; cA = nA; cB = nB; ++ui;
        if constexpr (Sched::GATHER) { vgc[0][0] = vgn[0][0]; vgc[0][1] = vgn[0][1]; vgc[1][0] = vgn[1][0]; vgc[1][1] = vgn[1][1]; }
    }
    PG8_WAIT_V(0);
    if (wr == 0) PG8_BAR;
    PG8_BAR;
#undef PG8_SA
#undef PG8_SB
#undef PG8_STAGE
#undef PG8_STAGE_A
#undef PG8_GLOAD
#undef PG8_LDA
#undef PG8_LDB
#undef PG8_MMA
#undef PG8_WAIT_V
#undef PG8_WAIT_L
#undef PG8_BAR
#undef PG8_SCHED
}

struct SchedDense {
    static constexpr bool GATHER = false;
    int nM, nN, nwg, G, c; const char* A; const char* Bt; size_t tstep; const int* idx;
    __device__ __forceinline__ void init(int M, int N, int K, int G_, int c_, const void* A_, const void* Bt_) { nM = M / BM; nN = N / BM; nwg = nM * nN; G = G_; c = c_; A = (const char*)A_; Bt = (const char*)Bt_; tstep = (size_t)BM * K * 2; idx = nullptr; }
    __device__ __forceinline__ bool next(int i, Unit& u) const {
        const long L = (long)i * G + c; if (L >= nwg) return false;
        int wgid = (int)L; { const int q = nwg / NXCD, r = nwg % NXCD, xcd = wgid % NXCD, off = wgid / NXCD; wgid = (xcd < r ? xcd * (q + 1) : r * (q + 1) + (xcd - r) * q) + off; }
        const int nig = WGM * nN, gid = wgid / nig, fm = gid * WGM, gsz = (nM - fm) < WGM ? (nM - fm) : WGM;
        u.pm = fm + ((wgid % nig) % gsz); u.pn = (wgid % nig) / gsz;
        u.A = A + (size_t)u.pm * tstep; u.B = Bt + (size_t)u.pn * tstep; return true;
    }
};
struct SchedCtxK {
    static constexpr bool GATHER = false;
    int c; const char* A; const char* Bt; const int* idx;
    __device__ __forceinline__ bool next(int i, Unit& u) const {
        if (i != 0 || c >= 40) return false;
        const int ks = c >> 3, pm = (c >> 2) & 1, pn = c & 3;
        u.pm = pm; u.pn = pn; u.aux = ks;
        u.A = A + ((size_t)pm * BM * MIXK + ks * 256) * 2; u.B = Bt + ((size_t)pn * BM * MIXK + ks * 256) * 2; return true;
    }
};
struct EpiSlab {
    static constexpr bool PERM = false;
    float* slab;
    __device__ __forceinline__ void operator()(const f32x4 (&acc)[2][2][4][2], const Unit& u, int wr, int wc, int fr, int fq) const {
        float* base = slab + ((size_t)u.aux * 512 + (size_t)u.pm * BM) * D;
        const int r0 = wr * 64 + fr, col0 = u.pn * BM + wc * 32 + 4 * fq;
#pragma unroll
        for (int ai = 0; ai < 2; ++ai)
#pragma unroll
            for (int m = 0; m < 4; ++m) { float* rowp = base + (size_t)(r0 + ai * HALF + m * 16) * D + col0;
#pragma unroll
                for (int bj = 0; bj < 2; ++bj)
#pragma unroll
                    for (int n = 0; n < 2; ++n) *(f32x4*)(rowp + bj * HALF + n * 16) = acc[ai][bj][m][n]; }
    }
};
struct SchedMoe1 {
    static constexpr bool GATHER = true;
    int c; bool has_ctx; const char* xe; const char* wgu; size_t tstep; const int* idx;
    __device__ __forceinline__ bool next(int i, Unit& u) const {
        int g, pn;
        if (i < 8) { const int q = i * 8 + (c & 7), j = c >> 3; g = q >> 1; u.pm = g * 8 + 4 * (q & 1) + (j & 3); pn = j >> 2; }
        else if (has_ctx && i == 8) { g = c >> 3; pn = c & 7; u.pm = 256 + g; }
        else return false;
        u.pn = pn; u.A = xe; u.B = wgu + ((size_t)(g & 15) * 8 + pn) * tstep; return true;
    }
};
struct SchedMoe2 {
    static constexpr bool GATHER = false;
    int c; bool has_ctx; const char* hid; const char* wd; size_t tstep; const int* idx;
    __device__ __forceinline__ bool next(int i, Unit& u) const {
        int g, pn;
        if (i < 4) { const int j = c >> 3; g = i * 8 + (c & 7); u.pm = g * 8 + (j & 7); pn = j >> 3; }
        else if (has_ctx && i == 4 && c < 128) { g = c >> 2; pn = c & 3; u.pm = 256 + g; }
        else return false;
        u.pn = pn; u.A = hid + (size_t)u.pm * tstep; u.B = wd + ((size_t)(g & 15) * 4 + pn) * tstep; return true;
    }
};

struct EpiBf16Plain {
    static constexpr bool PERM = true;
    bf16_t* O; int ldc;
    __device__ __forceinline__ void operator()(const f32x4 (&acc)[2][2][4][2], const Unit& u, int wr, int wc, int fr, int fq) const {
        const int row0 = u.pm * BM + wr * 64 + fr, col0 = u.pn * BM + wc * 32 + 8 * fq;
#pragma unroll
        for (int ai = 0; ai < 2; ++ai)
#pragma unroll
            for (int m = 0; m < 4; ++m) { bf16_t* rowp = O + (size_t)(row0 + ai * HALF + m * 16) * ldc + col0;
#pragma unroll
                for (int bj = 0; bj < 2; ++bj) { const f32x4 v0 = acc[ai][bj][m][0], v1 = acc[ai][bj][m][1];
                    u32x4 w; w.x = cvt_pk(v0[0], v0[1]); w.y = cvt_pk(v0[2], v0[3]); w.z = cvt_pk(v1[0], v1[1]); w.w = cvt_pk(v1[2], v1[3]);
                    *(u32x4*)(rowp + bj * HALF) = w; } }
    }
};
struct EpiResid {
    static constexpr bool PERM = false;
    float* hlat; float* hctx; const float* mods_l;
    __device__ __forceinline__ void operator()(const f32x4 (&acc)[2][2][4][2], const Unit& u, int wr, int wc, int fr, int fq) const {
        const int rowt = u.pm * BM;
        float* base; int s;
        if (rowt < LAT) { base = hlat + (size_t)rowt * D; s = rowt / T; } else { base = hctx + (size_t)(rowt - LAT) * D; s = 2; }
        const float* g1 = mods_l + s * 6144 + 2048;
        const int r0 = wr * 64 + fr, col0 = u.pn * BM + wc * 32 + 4 * fq;
        f32x4 gv[2][2];
#pragma unroll
        for (int bj = 0; bj < 2; ++bj)
#pragma unroll
            for (int n = 0; n < 2; ++n) gv[bj][n] = *(const f32x4*)(g1 + col0 + bj * HALF + n * 16);
#pragma unroll
        for (int ai = 0; ai < 2; ++ai) {
            f32x4 rv[4][2][2];
#pragma unroll
            for (int m = 0; m < 4; ++m)
#pragma unroll
                for (int bj = 0; bj < 2; ++bj)
#pragma unroll
                    for (int n = 0; n < 2; ++n) rv[m][bj][n] = *(const f32x4*)((const char*)base + (unsigned)(((r0 + ai * HALF + m * 16) * D + col0 + bj * HALF + n * 16) * 4));
            __builtin_amdgcn_sched_barrier(0);
#pragma unroll
            for (int m = 0; m < 4; ++m)
#pragma unroll
                for (int bj = 0; bj < 2; ++bj)
#pragma unroll
                    for (int n = 0; n < 2; ++n) *(f32x4*)((char*)base + (unsigned)(((r0 + ai * HALF + m * 16) * D + col0 + bj * HALF + n * 16) * 4)) = rv[m][bj][n] + gv[bj][n] * acc[ai][bj][m][n];
            __builtin_amdgcn_sched_barrier(0); }
    }
};
struct EpiSwiglu {
    static constexpr bool PERM = true;
    bf16_t* hid;
    __device__ __forceinline__ void operator()(const f32x4 (&acc)[2][2][4][2], const Unit& u, int wr, int wc, int fr, int fq) const {
        const int row0 = u.pm * BM + wr * 64 + fr, f0 = u.pn * HALF + wc * 32 + 8 * fq;
#pragma unroll
        for (int ai = 0; ai < 2; ++ai)
#pragma unroll
            for (int m = 0; m < 4; ++m) { bf16_t* rowp = hid + (size_t)(row0 + ai * HALF + m * 16) * D + f0;
                float o[8];
#pragma unroll
                for (int n = 0; n < 2; ++n)
#pragma unroll
                    for (int j = 0; j < 4; ++j) { const float g = acc[ai][0][m][n][j], up = acc[ai][1][m][n][j]; o[n * 4 + j] = g * __builtin_amdgcn_rcpf(1.0f + __expf(-g)) * up; }
                u32x4 w; w.x = cvt_pk(o[0], o[1]); w.y = cvt_pk(o[2], o[3]); w.z = cvt_pk(o[4], o[5]); w.w = cvt_pk(o[6], o[7]);
                *(u32x4*)rowp = w; }
    }
};
struct EpiScaleRow {
    static constexpr bool PERM = true;
    bf16_t* O; const float* gate;
    __device__ __forceinline__ void operator()(const f32x4 (&acc)[2][2][4][2], const Unit& u, int wr, int wc, int fr, int fq) const {
        const int row0 = u.pm * BM + wr * 64 + fr, col0 = u.pn * BM + wc * 32 + 8 * fq;
        float gsv[2][4];
#pragma unroll
        for (int ai = 0; ai < 2; ++ai)
#pragma unroll
            for (int m = 0; m < 4; ++m) gsv[ai][m] = gate[row0 + ai * HALF + m * 16];
        __builtin_amdgcn_sched_barrier(0);
#pragma unroll
        for (int ai = 0; ai < 2; ++ai)
#pragma unroll
            for (int m = 0; m < 4; ++m) { const int row = row0 + ai * HALF + m * 16; const float gs = gsv[ai][m]; bf16_t* rowp = O + (size_t)row * D + col0;
#pragma unroll
                for (int bj = 0; bj < 2; ++bj) { const f32x4 v0 = acc[ai][bj][m][0] * gs, v1 = acc[ai][bj][m][1] * gs;
                    u32x4 w; w.x = cvt_pk(v0[0], v0[1]); w.y = cvt_pk(v0[2], v0[3]); w.z = cvt_pk(v1[0], v1[1]); w.w = cvt_pk(v1[2], v1[3]);
                    *(u32x4*)(rowp + bj * HALF) = w; } }
    }
};
}

template <int K>
__device__ __forceinline__ f32x4 mm16(const unsigned char* X, int ldx, int x0, const unsigned char* Y, int ldy, int y0, f32x4 acc, int lane) {
    const int r = lane & 15, g = lane >> 4;
#pragma unroll
    for (int k0 = 0; k0 < K; k0 += 32) {
        const bf16x8 xf = *(const bf16x8*)(X + ((size_t)(x0 + r) * ldx + k0 + 8 * g) * 2);
        const bf16x8 yf = *(const bf16x8*)(Y + ((size_t)(y0 + r) * ldy + k0 + 8 * g) * 2);
        acc = __builtin_amdgcn_mfma_f32_16x16x32_bf16(yf, xf, acc, 0, 0, 0);
    }
    return acc;
}
#define SL(i) (smem + (i) * SLOT)
__device__ __forceinline__ int moff(int row, int col) { return row * 128 + ((((col >> 3) ^ ((row >> 1) & 7)) << 4) | ((col & 7) << 1)); }
__device__ __forceinline__ void st_row4(unsigned char* M, int x, int y, f32x4 v) { u32x2 w; w.x = cvt_pk(v[0], v[1]); w.y = cvt_pk(v[2], v[3]); *(u32x2*)(M + moff(x, y)) = w; }
__device__ __forceinline__ void st_col4(unsigned char* M, int x, int y, f32x4 v) {
    const int m0 = moff(y, x), m2 = moff(y + 2, x); const unsigned p01 = cvt_pk(v[0], v[1]), p23 = cvt_pk(v[2], v[3]);
    *(bf16_t*)(M + m0) = (bf16_t)(p01 & 0xffffu); *(bf16_t*)(M + m0 + 128) = (bf16_t)(p01 >> 16);
    *(bf16_t*)(M + m2) = (bf16_t)(p23 & 0xffffu); *(bf16_t*)(M + m2 + 128) = (bf16_t)(p23 >> 16);
}
__device__ __forceinline__ f32x4 ld_row4(const unsigned char* M, int x, int y) { const u32x2 w = *(const u32x2*)(M + moff(x, y));
    return (f32x4){bf2f(w.x & 0xffffu), bf2f(w.x >> 16), bf2f(w.y & 0xffffu), bf2f(w.y >> 16)}; }
__device__ __forceinline__ void unpack8(const bf16x8 v, float* o) {
#pragma unroll
    for (int j = 0; j < 8; ++j) o[j] = bf2f((unsigned short)v[j]);
}
__device__ __forceinline__ bf16x8 pack8(const float* o) { u32x4 w; w.x = cvt_pk(o[0], o[1]); w.y = cvt_pk(o[2], o[3]); w.z = cvt_pk(o[4], o[5]); w.w = cvt_pk(o[6], o[7]); return __builtin_bit_cast(bf16x8, w); }

__device__ __forceinline__ void conv8(const bf16_t* p, const float* sw  , int row, int lo, int hi, int col, float* u) {
    bf16x8 x[3]; f32x4 w0[3], w1[3];
#pragma unroll
    for (int dt = 0; dt < 3; ++dt) { const int rr = row + dt - 1, rc = min(max(rr, lo), hi - 1);
        x[dt] = *(const bf16x8*)(p + (size_t)rc * INC + col);
        const float m = (rr >= lo && rr < hi) ? 1.0f : 0.0f;
        w0[dt] = *(const f32x4*)(sw + dt * 1792 + col) * m; w1[dt] = *(const f32x4*)(sw + dt * 1792 + col + 4) * m; }
#pragma unroll
    for (int j = 0; j < 8; ++j) u[j] = 0.f;
#pragma unroll
    for (int dt = 0; dt < 3; ++dt) { float xf[8]; unpack8(x[dt], xf);
#pragma unroll
        for (int j = 0; j < 4; ++j) { u[j] += xf[j] * w0[dt][j]; u[4 + j] += xf[4 + j] * w1[dt][j]; } }
}
__device__ __forceinline__ f32x4 conv4(const bf16_t* p, const float* sw, int row, int lo, int hi, int col) {
    u32x2 x[3]; f32x4 w[3];
#pragma unroll
    for (int dt = 0; dt < 3; ++dt) { const int rr = row + dt - 1, rc = min(max(rr, lo), hi - 1);
        x[dt] = *(const u32x2*)(p + (size_t)rc * INC + col);
        w[dt] = *(const f32x4*)(sw + dt * 1792 + col) * ((rr >= lo && rr < hi) ? 1.0f : 0.0f); }
    f32x4 u = {0.f, 0.f, 0.f, 0.f};
#pragma unroll
    for (int dt = 0; dt < 3; ++dt) { u[0] += bf2f(x[dt].x & 0xffffu) * w[dt][0]; u[1] += bf2f(x[dt].x >> 16) * w[dt][1]; u[2] += bf2f(x[dt].y & 0xffffu) * w[dt][2]; u[3] += bf2f(x[dt].y >> 16) * w[dt][3]; }
    return u;
}

__device__ __forceinline__ f32x4 conv4l(const bf16_t* p, const float* wl, int row, int lo, int hi, int col) {
    u32x2 x[3]; f32x4 w[3];
#pragma unroll
    for (int dt = 0; dt < 3; ++dt) { const int rr = row + dt - 1, rc = min(max(rr, lo), hi - 1);
        x[dt] = *(const u32x2*)(p + (size_t)rc * INC + col);
        w[dt] = *(const f32x4*)(wl + dt * 64) * ((rr >= lo && rr < hi) ? 1.0f : 0.0f); }
    f32x4 u = {0.f, 0.f, 0.f, 0.f};
#pragma unroll
    for (int dt = 0; dt < 3; ++dt) { u[0] += bf2f(x[dt].x & 0xffffu) * w[dt][0]; u[1] += bf2f(x[dt].x >> 16) * w[dt][1]; u[2] += bf2f(x[dt].y & 0xffffu) * w[dt][2]; u[3] += bf2f(x[dt].y >> 16) * w[dt][3]; }
    return u;
}

__device__ __forceinline__ void ph_mods(const Params& P0, unsigned char* smem, int bid, int nblk) {
    const Params P = launder(P0);
    const int tid = opaque_tid();
    float* sil = (float*)smem;
    float* red = (float*)(smem + 12288);
    for (int i = tid; i < 3072; i += NT) { const float x = (i < 2048) ? P.in[1][i] : P.in[3][i - 2048]; sil[i] = x / (1.0f + __expf(-x)); }
    __syncthreads();
    float* mods = (float*)(P.ws + OFF_MODS);
    const int c = tid & 15, ks = tid >> 4;
    for (int it0 = bid; it0 < 768; it0 += 3 * nblk) {
        float a[3][3];
        const float* w[3];
#pragma unroll
        for (int u = 0; u < 3; ++u) { const int item = min(it0 + u * nblk, 767); a[u][0] = a[u][1] = a[u][2] = 0.f;
            w[u] = P.in[4] + (size_t)(item / 384) * D * 6144 + (item % 384) * 16 + c + (size_t)(ks * 32) * 6144; }
#pragma unroll 8
        for (int k = 0; k < 32; ++k) { const float s0 = sil[ks * 32 + k], s1 = sil[1024 + ks * 32 + k], s2 = sil[2048 + ks * 32 + k];
#pragma unroll
            for (int u = 0; u < 3; ++u) { const float wv = w[u][(size_t)k * 6144]; a[u][0] += s0 * wv; a[u][1] += s1 * wv; a[u][2] += s2 * wv; } }
#pragma unroll
        for (int u = 0; u < 3; ++u) { red[((u * 32 + ks) * 16 + c) * 3 + 0] = a[u][0]; red[((u * 32 + ks) * 16 + c) * 3 + 1] = a[u][1]; red[((u * 32 + ks) * 16 + c) * 3 + 2] = a[u][2]; }
        __syncthreads();
        if (tid < 144) { const int u = tid / 48, s = (tid % 48) >> 4, cc = tid & 15, item = it0 + u * nblk;
            if (item < 768) { float sum = 0.f;
                for (int q = 0; q < 32; ++q) sum += red[((u * 32 + q) * 16 + cc) * 3 + s];
                const int l = item / 384, colo = (item % 384) * 16 + cc;
                mods[(size_t)(l * 3 + s) * 6144 + colo] = sum + P.in[5][l * 6144 + colo]; } }
        __syncthreads();
    }
}
__device__ __forceinline__ void transpose_tile(const float* src, int N, bf16_t* dst, int dld, int kind, int tk, int tn, unsigned char* smem) {
    const int tid = opaque_tid();
    float* tile = (float*)smem;
#pragma unroll
    for (int i = 0; i < 2; ++i) { const int e = tid + i * NT, kk = e >> 4, n4 = (e & 15) * 4;
        const f32x4 v = *(const f32x4*)(src + (size_t)(tk * 64 + kk) * N + tn * 64 + n4);
        tile[kk * 65 + n4] = v[0]; tile[kk * 65 + n4 + 1] = v[1]; tile[kk * 65 + n4 + 2] = v[2]; tile[kk * 65 + n4 + 3] = v[3]; }
    __syncthreads();
    { const int n = tid >> 3, k8 = (tid & 7) * 8; float o[8];
#pragma unroll
      for (int j = 0; j < 8; ++j) o[j] = tile[(k8 + j) * 65 + n];
      const int ng = tn * 64 + n; int row = ng; if (kind == 1) row = (ng >> 7) * 256 + (ng & 127); else if (kind == 2) row = (ng >> 7) * 256 + 128 + (ng & 127);
      *(bf16x8*)(dst + (size_t)row * dld + tk * 64 + k8) = pack8(o); }
    __syncthreads();
}
__device__ __forceinline__ void ph_prep_weights(const Params& P0, unsigned char* smem, int bid, int nblk) {
    const Params P = launder(P0);
    for (int t = bid; t < 2 * 576; t += nblk) { const int l = t / 576, r = t % 576, tk = r / 36, tn = r % 36;
        transpose_tile(P.in[8] + (size_t)l * D * INC, INC, (bf16_t*)(P.ws + OFF_WINT) + (size_t)l * INC * D, D, 0, tk, tn, smem); }
    for (int t = bid; t < 2 * 128; t += nblk) { const int l = t / 128, r = t % 128, tk = r / 16, tn = r % 16;
        transpose_tile(P.in[23] + (size_t)l * D * D, D, (bf16_t*)(P.ws + OFF_WOT) + (size_t)l * D * MIXK, MIXK, 0, tk, tn, smem); }
    for (int t = bid; t < 64; t += nblk) { const int which = t / 32, r = t % 32, m = r / 8, tn = r % 8;
        transpose_tile((which ? P.in[13] : P.in[11]) + (size_t)m * 64 * 512, 512, (bf16_t*)(P.ws + (which ? OFF_IUPT : OFF_DUPT)) + (size_t)m * 512 * 64, 64, 0, 0, tn, smem); }
    for (int t = bid; t < 32; t += nblk) { const int l = t / 16, r = t % 16, tk = r / 8, tn = r % 8;
        transpose_tile(P.in[14] + (size_t)l * 128 * 512, 512, (bf16_t*)(P.ws + OFF_GUPT) + (size_t)l * 512 * 128, 128, 0, tk, tn, smem); }
}
__device__ __forceinline__ void ph_tables(const Params& P0, int bid, int nblk) {
    const Params P = launder(P0);
    const int gt = bid * NT + opaque_tid(), ngt = nblk * NT;
    bf16_t* D1 = (bf16_t*)(P.ws + OFF_D1); bf16_t* DC = (bf16_t*)(P.ws + OFF_DCTX); bf16_t* E2 = (bf16_t*)(P.ws + OFF_E2);
    for (int i = gt; i < 256 * 128; i += ngt) { const int m = i >> 7, t1 = i & 127, k1 = m & 127, ph = (k1 * t1) & 127; float s, c; sincospif((float)ph * (1.0f / 64.0f), &s, &c);
        D1[i] = f2bf((m < 128 ? c : -s) * (1.0f / 32.0f)); }
    for (int i = gt; i < 512 * 256; i += ngt) { const int m = i >> 8, t = i & 255, k = m & 255, ph = (k * t) & 255; float s, c; sincospif((float)ph * (1.0f / 128.0f), &s, &c);
        DC[i] = f2bf((m < 256 ? c : -s) * (1.0f / 128.0f)); }
    for (int i = gt; i < 128 * 256 * 256; i += ngt) { const int k1 = i >> 16, m = (i >> 8) & 255, kk = i & 255, k2 = m & 127, t2 = kk & 127, ph = (t2 * (k1 + 128 * k2)) & 16383;
        float s, c; sincospif((float)ph * (1.0f / 8192.0f), &s, &c);
        const float v = (m < 128) ? (kk < 128 ? c : s) : (kk < 128 ? -s : c);
        E2[i] = f2bf(v * (1.0f / 32.0f)); }
}
__device__ __forceinline__ void ph_fold(const Params& P0, unsigned char* smem, int bid, int nblk) {
    const Params P = launder(P0);
    const int tid = opaque_tid();
    float* coef = (float*)smem;
    float* fwl = (float*)(smem + 16384);
    float* trg = (float*)(smem + 32768);
    for (int item = bid; item < 2 * 12 * 4; item += nblk) {
        const int nq = item & 3, grp = (item >> 2) % 12, l = (item >> 2) / 12;
        const float* wo = P.in[23] + (size_t)l * D * D;
        int rowbase, kbase;
        if (grp < 4) { rowbase = 512 + grp * 64; kbase = 512 + grp * 64;
            for (int e = tid; e < 4096; e += NT) { const int cc = e >> 6, d = e & 63; coef[e] = P.in[20][((size_t)(l * 4 + grp) * 64 + cc) * 64 + d] * P.in[21][l * 256 + grp * 64 + d]; }
        } else { const int hh = (grp - 4) >> 1, reim = (grp - 4) & 1; rowbase = 768 + hh * 64; kbase = 768 + hh * 128 + reim * 64;
            for (int e = tid; e < 4096; e += NT) fwl[e] = P.in[22][(size_t)(l * 4 + hh) * 4096 + e];
            if (tid < 64) { float sn, cs; sincospif((float)tid * (1.0f / 32.0f), &sn, &cs); trg[tid] = reim ? sn : cs; }
            __syncthreads();
            for (int e = tid; e < 4096; e += NT) { const int c = e >> 6, d = e & 63; float acc = 0.f;
                for (int m = 0; m < 64; ++m) acc += trg[(c * m) & 63] * fwl[m * 64 + d];
                coef[e] = acc; } }
        __syncthreads();
        { const int n = nq * 256 + (tid & 255), kh = tid >> 8; float w[64];
#pragma unroll
          for (int d = 0; d < 64; ++d) w[d] = wo[(size_t)(rowbase + d) * D + n];
          bf16_t* dst = (bf16_t*)(P.ws + OFF_WOT) + ((size_t)l * D + n) * MIXK + kbase + kh * 32;
#pragma unroll 1
          for (int kk = 0; kk < 32; ++kk) { const float* cf = coef + (kh * 32 + kk) * 64; float acc = 0.f;
#pragma unroll
              for (int d = 0; d < 64; d += 4) { const f32x4 c4 = *(const f32x4*)(cf + d); acc += (c4[0] * w[d] + c4[1] * w[d + 1]) + (c4[2] * w[d + 2] + c4[3] * w[d + 3]); }
              dst[kk] = f2bf(acc); } }
        __syncthreads();
    }
}
__device__ __forceinline__ void ph_norm1(const Params& P0, int mode, unsigned char* smem, int bid, int nblk) {
    const Params P = launder(P0);
    const int lane = opaque_tid() & 63, gw = bid * 8 + (opaque_tid() >> 6), ngw = nblk * 8;
    const float* mods = (const float*)(P.ws + OFF_MODS);
    float* hctx = (float*)(P.ws + OFF_HCTX);
    const int* inv = (const int*)(P.ws + OFF_INV);
    const bf16_t* ye = (const bf16_t*)(P.ws + OFF_XE);
    bf16_t* xn = (bf16_t*)(P.ws + OFF_XN);
    const int nrows = (mode == 2) ? LAT : MT;
    const int lcur = (mode == 2) ? 1 : mode, lprev = lcur - (mode == 2 ? 0 : 1);
    const float* gn = (mode == 2) ? P.in[28] : P.in[6] + lcur * D;
    float* GA = (float*)smem; float* SB = GA + 3072; float* G2 = SB + 3072;
    { const int t_ = opaque_tid();
      for (int i = t_; i < 3072; i += NT) { const int s_ = i >> 10, c_ = i & 1023;
          if (mode == 2) { GA[i] = gn[c_]; SB[i] = 0.f; }
          else { const float* sh_ = mods + (size_t)(lcur * 3 + s_) * 6144; GA[i] = gn[c_] * (sh_[1024 + c_] + 1.0f); SB[i] = sh_[c_]; }
          G2[i] = (mode != 0) ? mods[(size_t)(lprev * 3 + s_) * 6144 + 5120 + c_] : 0.f; }
      __syncthreads(); }
#define N1_SRC(r_) ((mode == 0) ? (((r_) < LAT) ? P.in[0] + (size_t)(r_) * D : P.in[2] + (size_t)((r_) - LAT) * D) : (((r_) < LAT) ? (const float*)P.out + (size_t)(r_) * D : (const float*)hctx + (size_t)((r_) - LAT) * D))
    f32x4 vn[4]; int ivn = -1;
    if (gw < nrows) {
#pragma unroll
        for (int i = 0; i < 4; ++i) vn[i] = *(const f32x4*)(N1_SRC(gw) + 4 * lane + 256 * i);
        if (mode != 0) ivn = inv[(size_t)gw * 16 + (lane & 15)]; }
    for (int r = gw; r < nrows; r += ngw) {
        const int s = (r < LAT) ? r / T : 2;
        float* hrow = (r < LAT) ? P.out + (size_t)r * D : hctx + (size_t)(r - LAT) * D;
        f32x4 v[4];
#pragma unroll
        for (int i = 0; i < 4; ++i) v[i] = vn[i];
        const int iv = ivn;
        { const int rn = r + ngw;
          if (rn < nrows) {
#pragma unroll
              for (int i = 0; i < 4; ++i) vn[i] = *(const f32x4*)(N1_SRC(rn) + 4 * lane + 256 * i);
              if (mode != 0) ivn = inv[(size_t)rn * 16 + (lane & 15)]; } }
        if (mode != 0) {
            f32x4 a[4] = {{0.f, 0.f, 0.f, 0.f}, {0.f, 0.f, 0.f, 0.f}, {0.f, 0.f, 0.f, 0.f}, {0.f, 0.f, 0.f, 0.f}};
            unsigned em = (unsigned)(__ballot(iv >= 0) & 0xFFFFull);
            while (em) {
                size_t yr[4]; float wq[4];
#pragma unroll
                for (int q = 0; q < 4; ++q) {
                    if (em) { const int e = __builtin_ctz(em); em &= em - 1u; const int slot = __builtin_amdgcn_readlane(iv, e);
                        yr[q] = (r < LAT) ? (size_t)((r / T) * 16 + e) * 2048 + slot : (size_t)65536 + (size_t)(((r - LAT) / TC) * 16 + e) * 256 + slot; wq[q] = 1.0f; }
                    else { yr[q] = 0; wq[q] = 0.0f; } }
                u32x2 w[4][4];
#pragma unroll
                for (int q = 0; q < 4; ++q)
#pragma unroll
                    for (int i = 0; i < 4; ++i) w[q][i] = *(const u32x2*)(ye + yr[q] * D + 4 * lane + 256 * i);
#pragma unroll
                for (int q = 0; q < 4; ++q)
#pragma unroll
                    for (int i = 0; i < 4; ++i) { a[i][0] += wq[q] * bf2f(w[q][i].x & 0xffffu); a[i][1] += wq[q] * bf2f(w[q][i].x >> 16); a[i][2] += wq[q] * bf2f(w[q][i].y & 0xffffu); a[i][3] += wq[q] * bf2f(w[q][i].y >> 16); }
            }
#pragma unroll
            for (int i = 0; i < 4; ++i) v[i] = v[i] + *(const f32x4*)(G2 + s * 1024 + 4 * lane + 256 * i) * a[i];
        }
        if (mode != 2) {
#pragma unroll
            for (int i = 0; i < 4; ++i) *(f32x4*)(hrow + 4 * lane + 256 * i) = v[i];
        }
        float ss = 0.f;
#pragma unroll
        for (int i = 0; i < 4; ++i) ss += (v[i][0] * v[i][0] + v[i][1] * v[i][1]) + (v[i][2] * v[i][2] + v[i][3] * v[i][3]);
        const float rs = rsqrtf(wave_sum(ss, lane) * (1.0f / D) + 1e-6f);
        if (mode == 2) {
#pragma unroll
            for (int i = 0; i < 4; ++i) *(f32x4*)(hrow + 4 * lane + 256 * i) = v[i] * rs * *(const f32x4*)(GA + 4 * lane + 256 * i);
        } else {
#pragma unroll
            for (int i = 0; i < 4; ++i) { const int c = 4 * lane + 256 * i;
                const f32x4 y = v[i] * rs * *(const f32x4*)(GA + s * 1024 + c) + *(const f32x4*)(SB + s * 1024 + c);
                u32x2 w; w.x = cvt_pk(y[0], y[1]); w.y = cvt_pk(y[2], y[3]); *(u32x2*)(xn + (size_t)r * D + c) = w; }
        }
    }
#undef N1_SRC
}

__device__ __forceinline__ void ph_sa(const Params& P0, int l, int b, unsigned char* smem, int bid, int nblk, int tbeg, int ntask) {
    const Params P = launder(P0);
    const int tid = opaque_tid(), lane = tid & 63, wid = __builtin_amdgcn_readfirstlane(tid >> 6), r = lane & 15, g = lane >> 4;
    const bf16_t* p = (const bf16_t*)(P.ws + OFF_P);
    const float* sw = P.in[9] + (size_t)l * 3 * 1792;
    float* LW = (float*)(smem + LDS_LW); float* SEG = (float*)(smem + LDS_SEG); float* GL = (float*)(smem + LDS_GL); float* BON = (float*)(smem + LDS_BON);
    float* bonus = (float*)(P.ws + OFF_BONUS);
    const int tx = wid & 3, ty0 = (wid >> 2) * 2;
    LAS unsigned char* ldsa = (LAS unsigned char*)smem;
#define SA_DMA_LORA(h_, d_) do { if (wid >= 6) { const bf16_t* w_ = (const bf16_t*)(P.ws + (wid == 6 ? OFF_DUPT : OFF_IUPT)) + (size_t)((l * 2 + (d_)) * 512 + (h_) * 64) * 64; \
        _Pragma("unroll") for (int i_ = 0; i_ < 8; ++i_) { const int row_ = 8 * i_ + (lane >> 3), cl_ = (lane & 7) ^ ((row_ >> 1) & 7); \
            __builtin_amdgcn_global_load_lds((const unsigned*)(w_ + row_ * 64 + cl_ * 8), (LAS unsigned*)(ldsa + (wid == 6 ? 5 : 6) * SLOT + i_ * 1024), 16, 0, 0); } } } while (0)
    int nrnd = 0; while ((nrnd + 1) * nblk <= ntask) ++nrnd;
    const int NFULL = nrnd * nblk, NHALF = 2 * (ntask - NFULL);
#define SA_UNIT(q_, tq_, d0_, d1_) do { if ((q_) < NFULL) { tq_ = (q_); d0_ = 0; d1_ = 2; } else if ((q_) - NFULL < NHALF) { tq_ = NFULL + (((q_) - NFULL) >> 1); d0_ = ((q_) - NFULL) & 1; d1_ = d0_ + 1; } else { tq_ = -1; d0_ = 0; d1_ = 0; } } while (0)
    __syncthreads();
    { int tq, d0, d1; SA_UNIT(bid, tq, d0, d1); if (tq >= 0) SA_DMA_LORA((tbeg + tq) / 260, d0); }
    for (int q = bid; ; q += nblk) {
        int tq, dbeg, dend; SA_UNIT(q, tq, dbeg, dend);
        if (tq < 0) break;
        const int h = (tbeg + tq) / 260, j = (tbeg + tq) % 260;
        int tok0, lo, hi;
        if (j < 4) { lo = LAT + b * TC; hi = lo + TC; tok0 = lo + 64 * j; } else { lo = b * T; hi = lo + T; tok0 = lo + 64 * (j - 4); }
        bf16x8 F[8];
        if (wid < 6) {
            const int gsel = (wid == 5) ? 1 : wid, tb = lane >> 3, c8 = (lane & 7) * 8;
            const int col = ((gsel < 3) ? gsel * 512 + h * 64 : (gsel == 3 ? 1536 : 1600)) + c8;
            bf16x8 xr[10]; f32x4 wa[3], wb[3];
#pragma unroll
            for (int k = 0; k < 10; ++k) { const int rc = min(max(tok0 + 8 * tb - 1 + k, lo), hi - 1); xr[k] = *(const bf16x8*)(p + (size_t)rc * INC + col); }
#pragma unroll
            for (int dt = 0; dt < 3; ++dt) { wa[dt] = *(const f32x4*)(sw + dt * 1792 + col); wb[dt] = *(const f32x4*)(sw + dt * 1792 + col + 4); }
            f32x4 kk0 = {1.f, 1.f, 1.f, 1.f}, kk1 = kk0;
            if (wid == 5) { kk0 = *(const f32x4*)(P.in[15] + l * 512 + h * 64 + c8); kk1 = *(const f32x4*)(P.in[15] + l * 512 + h * 64 + c8 + 4); }
            const float mfirst = (tok0 + 8 * tb - 1 >= lo) ? 1.0f : 0.0f, mlast = (tok0 + 8 * tb + 8 < hi) ? 1.0f : 0.0f;
#pragma unroll
            for (int tt = 0; tt < 8; ++tt) { float u[8];
#pragma unroll
                for (int jj = 0; jj < 8; ++jj) u[jj] = 0.f;
#pragma unroll
                for (int dt = 0; dt < 3; ++dt) { float xf[8]; unpack8(xr[tt + dt], xf);
                    const float m = (tt == 0 && dt == 0) ? mfirst : ((tt == 7 && dt == 2) ? mlast : 1.0f);
#pragma unroll
                    for (int jj = 0; jj < 4; ++jj) { u[jj] += xf[jj] * wa[dt][jj] * m; u[4 + jj] += xf[4 + jj] * wb[dt][jj] * m; } }
                if (wid == 3) {
#pragma unroll
                    for (int jj = 0; jj < 8; ++jj) u[jj] = 1.0f - 2.0f * __builtin_amdgcn_rcpf(__expf(2.0f * u[jj]) + 1.0f); }
                if (wid == 5) { float ss = 0.f;
#pragma unroll
                    for (int jj = 0; jj < 8; ++jj) { u[jj] *= (jj < 4 ? kk0[jj] : kk1[jj - 4]); ss += u[jj] * u[jj]; }
                    ss += sx<1>(ss, lane); ss += sx<2>(ss, lane); ss += sx<4>(ss, lane);
                    const float inv = rsqrtf(ss + 1e-12f);
#pragma unroll
                    for (int jj = 0; jj < 8; ++jj) u[jj] *= inv; }
                F[tt] = pack8(u); }
        }
#pragma unroll 1
      for (int d = dbeg; d < dend; ++d) {
        const int n = (d == 0) ? j : ((j < 4) ? 3 - j : 263 - j);
        unsigned char* gout = P.ws + ((b == 1 && h < 2) ? OFF_GH2 : OFF_GH) + (size_t)((h * 2 + d) * 260 + n) * 16384;
        unsigned char* gyout = P.ws + OFF_GY + (size_t)(((b * 8 + h) * 2 + d) * 260 + n) * 16384;
        f32x4 kav[2], rkv[2], w0v[2], a0v[2];
#pragma unroll
        for (int tyi = 0; tyi < 2; ++tyi) { w0v[tyi] = *(const f32x4*)(P.in[10] + (l * 2 + d) * 512 + h * 64 + 16 * (ty0 + tyi) + 4 * g); a0v[tyi] = *(const f32x4*)(P.in[12] + (l * 2 + d) * 512 + h * 64 + 16 * (ty0 + tyi) + 4 * g);
            kav[tyi] = *(const f32x4*)(P.in[16] + l * 512 + h * 64 + 16 * (ty0 + tyi) + 4 * g); rkv[tyi] = *(const f32x4*)(P.in[17] + l * 512 + h * 64 + 16 * (ty0 + tyi) + 4 * g); }
        { if (wid < 6) { const int sl = (wid == 0) ? 8 : (wid == 1) ? 9 : (wid == 2) ? 11 : (wid == 3) ? 12 : (wid == 4) ? 13 : 10, tb = lane >> 3, c8 = (lane & 7) * 8;
#pragma unroll
              for (int tt = 0; tt < 8; ++tt) *(bf16x8*)(SL(sl) + moff(8 * tb + tt, c8)) = F[tt]; }
          if (tid < 64) BON[tid] = 0.f; }
        if (wid >= 6) asm volatile("s_waitcnt vmcnt(0)" ::: "memory");
        __syncthreads();
        { const int t = 16 * tx + r; float bon = 0.f;
#pragma unroll
          for (int tyi = 0; tyi < 2; ++tyi) { const int cy = ty0 + tyi;
            f32x4 aw = {0.f, 0.f, 0.f, 0.f}, aa = {0.f, 0.f, 0.f, 0.f};
#pragma unroll
            for (int ks = 0; ks < 2; ++ks) {
                const bf16x8 xw = *(const bf16x8*)(SL(12) + moff(t, 32 * ks + 8 * g)), xa = *(const bf16x8*)(SL(13) + moff(t, 32 * ks + 8 * g));
                const bf16x8 ywf = *(const bf16x8*)(SL(5) + moff(16 * cy + r, 32 * ks + 8 * g)), yaf = *(const bf16x8*)(SL(6) + moff(16 * cy + r, 32 * ks + 8 * g));
                aw = __builtin_amdgcn_mfma_f32_16x16x32_bf16(ywf, xw, aw, 0, 0, 0); aa = __builtin_amdgcn_mfma_f32_16x16x32_bf16(yaf, xa, aa, 0, 0, 0); }
            const int c = 16 * cy + 4 * g, hc = h * 64 + c;
            const f32x4 w0 = w0v[tyi], a0 = a0v[tyi];
            const f32x4 ka = kav[tyi], rk = rkv[tyi];
            const f32x4 kv = ld_row4(SL(9), t, c), kkv = ld_row4(SL(10), t, c), rv = ld_row4(SL(8), t, c);
            f32x4 lw, kd, bb;
#pragma unroll
            for (int j = 0; j < 4; ++j) { const float x = -(w0[j] + aw[j]);
                lw[j] = -0.60653065971f * __builtin_amdgcn_rcpf(1.0f + __expf(x));
                const float al = sigmoidf_(a0[j] + aa[j]);
                kd[j] = kv[j] * (1.0f + (al - 1.0f) * ka[j]); bb[j] = kkv[j] * al; bon += rv[j] * kd[j] * rk[j]; }
            *(f32x4*)(LW + t * 68 + c) = lw;
            st_row4(SL(9), t, c, kd); st_row4(SL(2), t, c, bb); }
          bon += sx<16>(bon, lane); bon += sx<32>(bon, lane);
          if (g == 0) atomicAdd(&BON[t], bon); }
        __syncthreads();
        if (tid < 64) bonus[((size_t)d * MT + tok0 + tid) * 8 + h] = BON[tid];
        { const int cp = tid & 31, c0 = 2 * cp, sq = tid >> 5;
          float lw0[4], lw1[4], cu0[4], cu1[4]; float run0 = 0.f, run1 = 0.f;
#pragma unroll
          for (int qq = 0; qq < 4; ++qq) { const int i = 4 * sq + qq, tl = d ? 63 - i : i; const f32x2 l2 = *(const f32x2*)(LW + tl * 68 + c0);
              lw0[qq] = l2[0]; lw1[qq] = l2[1]; run0 += l2[0]; run1 += l2[1]; cu0[qq] = run0; cu1[qq] = run1; }
          *(f32x2*)(SEG + sq * 64 + c0) = (f32x2){run0, run1};
          unsigned rv2[4], kd2[4], kk2[4], vv2[4], bb2[4];
          const int stp = d ? -128 : 128, mt0 = moff(d ? 63 - 4 * sq : 4 * sq, c0), mt2 = moff(d ? 61 - 4 * sq : 4 * sq + 2, c0);
#pragma unroll
          for (int qq = 0; qq < 4; ++qq) { const int mo = ((qq & 2) ? mt2 : mt0) + (qq & 1) * stp;
              rv2[qq] = *(const unsigned*)(SL(8) + mo); kd2[qq] = *(const unsigned*)(SL(9) + mo); kk2[qq] = *(const unsigned*)(SL(10) + mo);
              vv2[qq] = *(const unsigned*)(SL(11) + mo); bb2[qq] = *(const unsigned*)(SL(2) + mo); }
          __syncthreads();
          float off0 = 0.f, off1 = 0.f, tot0 = 0.f, tot1 = 0.f;
#pragma unroll
          for (int s2 = 0; s2 < 16; ++s2) { const f32x2 sv = *(const f32x2*)(SEG + s2 * 64 + c0); tot0 += sv[0]; tot1 += sv[1]; off0 += (s2 < sq) ? sv[0] : 0.f; off1 += (s2 < sq) ? sv[1] : 0.f; }
          u32x2 tat0, tat1, tbh0, tbh1, tkh0, tkh1;
          const float gl0 = __expf(tot0), gl1 = __expf(tot1);
          float pe0 = __expf(off0), pe1 = __expf(off1);
#pragma unroll
          for (int qp = 0; qp < 2; ++qp) { float a0[2], a1[2], b0[2], b1[2], k0[2], k1[2];
#pragma unroll
            for (int q2 = 0; q2 < 2; ++q2) { const int qq = 2 * qp + q2; const int mo = moff(4 * sq + 2 * qp, c0) + q2 * 128;
              const float cm0 = off0 + cu0[qq], cm1 = off1 + cu1[qq];
              const float e0 = __expf(cm0), ei0 = __builtin_amdgcn_rcpf(e0), ep0 = pe0, eh0 = gl0 * ei0;
              const float e1 = __expf(cm1), ei1 = __builtin_amdgcn_rcpf(e1), ep1 = pe1, eh1 = gl1 * ei1;
              pe0 = e0; pe1 = e1;
              const float kk0 = bf2f(kk2[qq] & 0xffffu), kk1 = bf2f(kk2[qq] >> 16), bb0 = bf2f(bb2[qq] & 0xffffu), bb1 = bf2f(bb2[qq] >> 16);
              const float kd0 = bf2f(kd2[qq] & 0xffffu), kd1 = bf2f(kd2[qq] >> 16), r0 = bf2f(rv2[qq] & 0xffffu), r1 = bf2f(rv2[qq] >> 16);
              a0[q2] = -kk0 * ep0; a1[q2] = -kk1 * ep1; b0[q2] = bb0 * eh0; b1[q2] = bb1 * eh1; k0[q2] = kd0 * eh0; k1[q2] = kd1 * eh1;
              *(unsigned*)(SL(0) + mo) = cvt_pk(a0[q2], a1[q2]);
              *(unsigned*)(SL(2) + mo) = cvt_pk(bb0 * ei0, bb1 * ei1);
              *(unsigned*)(SL(3) + mo) = cvt_pk(kd0 * ei0, kd1 * ei1);
              *(unsigned*)(SL(4) + mo) = cvt_pk(r0 * e0, r1 * e1); }
            const unsigned pa0 = cvt_pk(a0[0], a0[1]), pa1 = cvt_pk(a1[0], a1[1]), pb0 = cvt_pk(b0[0], b0[1]), pb1 = cvt_pk(b1[0], b1[1]), pk0 = cvt_pk(k0[0], k0[1]), pk1 = cvt_pk(k1[0], k1[1]);
            if (qp == 0) { tat0.x = pa0; tat1.x = pa1; tbh0.x = pb0; tbh1.x = pb1; tkh0.x = pk0; tkh1.x = pk1; } else { tat0.y = pa0; tat1.y = pa1; tbh0.y = pb0; tbh1.y = pb1; tkh0.y = pk0; tkh1.y = pk1; } }
          { const int m0 = moff(c0, 4 * sq), m1 = moff(c0 + 1, 4 * sq);
            *(u32x2*)(SL(1) + m0) = tat0; *(u32x2*)(SL(1) + m1) = tat1;
            *(u32x2*)(SL(5) + m0) = tbh0; *(u32x2*)(SL(5) + m1) = tbh1;
            *(u32x2*)(SL(6) + m0) = tkh0; *(u32x2*)(SL(6) + m1) = tkh1;
            *(u32x2*)(SL(7) + m0) = (u32x2){(vv2[0] & 0xffffu) | (vv2[1] << 16), (vv2[2] & 0xffffu) | (vv2[3] << 16)};
            *(u32x2*)(SL(7) + m1) = (u32x2){(vv2[0] >> 16) | (vv2[1] & 0xffff0000u), (vv2[2] >> 16) | (vv2[3] & 0xffff0000u)}; }
          if (sq == 0) { GL[c0] = gl0; GL[c0 + 1] = gl1; } }
        __syncthreads();
        const f32x4 zero = {0.f, 0.f, 0.f, 0.f};
        int rq = r, gq = g, lq = lane; asm volatile("" : "+v"(rq), "+v"(gq), "+v"(lq));
        const int x = 16 * tx + rq;
#define FRX(slot, ks) (*(const bf16x8*)(SL(slot) + moff(16 * tx + rq, 32 * (ks) + 8 * gq)))
#define FRY(slot, tyi, ks) (*(const bf16x8*)(SL(slot) + moff(16 * (ty0 + (tyi)) + rq, 32 * (ks) + 8 * gq)))
#define MF(a, yf, xf) a = __builtin_amdgcn_mfma_f32_16x16x32_bf16(yf, xf, a, 0, 0, 0)
#define LDX(v, slot) bf16x8 v[2]; v[0] = FRX(slot, 0); v[1] = FRX(slot, 1)
#define LDY(v, slot) bf16x8 v[2][2]; v[0][0] = FRY(slot, 0, 0); v[0][1] = FRY(slot, 0, 1); v[1][0] = FRY(slot, 1, 0); v[1][1] = FRY(slot, 1, 1)
#define MM2(acc, yv, xv) do { MF(acc[0], yv[0][0], xv[0]); MF(acc[1], yv[1][0], xv[0]); MF(acc[0], yv[0][1], xv[1]); MF(acc[1], yv[1][1], xv[1]); } while (0)
#define YOF(tyi) (16 * (ty0 + (tyi)) + 4 * gq)
        { LDX(x0, 0); LDX(x3, 3); LDX(x4, 4); LDY(y2, 2); LDY(y0, 0); LDY(y3, 3);
          __builtin_amdgcn_sched_barrier(0);
          f32x4 an[2] = {zero, zero}, ak[2] = {zero, zero}, ab[2] = {zero, zero}, ar[2] = {zero, zero};
          MM2(an, y2, x0); MM2(ak, y0, x3); MM2(ab, y2, x4); MM2(ar, y3, x4);
#pragma unroll
          for (int tyi = 0; tyi < 2; ++tyi) { const int y = YOF(tyi); f32x4 tt;
#pragma unroll
            for (int j = 0; j < 4; ++j) { an[tyi][j] = (x > y + j) ? an[tyi][j] : 0.f; tt[j] = an[tyi][j] + ((x == y + j) ? 1.0f : 0.f);
                ak[tyi][j] = (x < y + j) ? ak[tyi][j] : 0.f;
                ab[tyi][j] = (y + j <= x) ? ab[tyi][j] : 0.f; ar[tyi][j] = (y + j <= x) ? ar[tyi][j] : 0.f; }
            st_row4(SL(8), x, y, an[tyi]); st_col4(SL(9), x, y, an[tyi]); st_row4(SL(13), x, y, tt);
            st_row4(SL(10), x, y, ak[tyi]); st_row4(SL(11), x, y, ab[tyi]); st_row4(SL(12), x, y, ar[tyi]); } }
        __syncthreads();
#define SQ_ONLY(xs, ys, on, om) do { LDX(xq, xs); LDY(yq, ys); __builtin_amdgcn_sched_barrier(0); f32x4 aq[2] = {zero, zero}; MM2(aq, yq, xq); \
            _Pragma("unroll") for (int tyi = 0; tyi < 2; ++tyi) { st_row4(SL(on), x, YOF(tyi), aq[tyi]); st_col4(SL(om), x, YOF(tyi), aq[tyi]); } } while (0)
#define TU_ONLY(xs, ys, os) do { LDX(xt, xs); LDY(yt, ys); f32x4 at[2]; at[0] = ld_row4(SL(xs), x, YOF(0)); at[1] = ld_row4(SL(xs), x, YOF(1)); __builtin_amdgcn_sched_barrier(0); MM2(at, yt, xt); \
            _Pragma("unroll") for (int tyi = 0; tyi < 2; ++tyi) st_row4(SL(os), x, YOF(tyi), at[tyi]); } while (0)
#define TU_SQ(txs, tys, tos, qxs, qys, qon, qom) do { LDX(xt, txs); LDY(yt, tys); LDX(xq, qxs); LDY(yq, qys); f32x4 at[2]; at[0] = ld_row4(SL(txs), x, YOF(0)); at[1] = ld_row4(SL(txs), x, YOF(1)); \
            __builtin_amdgcn_sched_barrier(0); f32x4 aq[2] = {zero, zero}; MM2(at, yt, xt); MM2(aq, yq, xq); \
            _Pragma("unroll") for (int tyi = 0; tyi < 2; ++tyi) { st_row4(SL(tos), x, YOF(tyi), at[tyi]); st_row4(SL(qon), x, YOF(tyi), aq[tyi]); st_col4(SL(qom), x, YOF(tyi), aq[tyi]); } } while (0)
        SQ_ONLY(8, 9, 0, 2); __syncthreads();
        TU_SQ(13, 2, 3, 0, 2, 8, 9); __syncthreads();
        TU_SQ(3, 9, 13, 8, 9, 0, 2); __syncthreads();
        TU_SQ(13, 2, 3, 0, 2, 8, 9); __syncthreads();
        TU_ONLY(3, 9, 13); __syncthreads();
#undef SQ_ONLY
#undef TU_ONLY
#undef TU_SQ
        { LDX(x1, 1); LDX(x10, 10); LDY(y13, 13);
          __builtin_amdgcn_sched_barrier(0);
          f32x4 ap[2] = {zero, zero}, aq[2] = {zero, zero};
          MM2(ap, y13, x1); MM2(aq, y13, x10);
#pragma unroll
          for (int tyi = 0; tyi < 2; ++tyi) { st_row4(SL(0), x, YOF(tyi), ap[tyi]); st_row4(SL(2), x, YOF(tyi), aq[tyi]); } }
        __syncthreads();
        { LDX(x11, 11); LDX(x5, 5); LDY(y0, 0); LDY(y2, 2);
          f32x4 agy[2], ags[2], awy[2], aws[2];
#pragma unroll
          for (int tyi = 0; tyi < 2; ++tyi) { const int y = YOF(tyi);
            agy[tyi] = ld_row4(SL(4), x, y); awy[tyi] = ld_row4(SL(12), x, y); aws[tyi] = ld_row4(SL(6), x, y);
#pragma unroll
            for (int j = 0; j < 4; ++j) ags[tyi][j] = (x == y + j) ? GL[x] : 0.f; }
          __builtin_amdgcn_sched_barrier(0);
          MM2(agy, y0, x11);
          MM2(ags, y0, x5);
          MM2(awy, y2, x11);
          MM2(aws, y2, x5);
#pragma unroll
          for (int tyi = 0; tyi < 2; ++tyi) { const int ty = ty0 + tyi, y = YOF(tyi);
            const size_t coff = ((size_t)((tx * 2 + (ty >> 1)) * 64 + lq) * 8 + 4 * (ty & 1)) * 2;
            { u32x2 w; w.x = cvt_pk(agy[tyi][0], agy[tyi][1]); w.y = cvt_pk(agy[tyi][2], agy[tyi][3]); *(u32x2*)(gyout + ((size_t)x * 64 + 32 * (ty >> 1) + 8 * gq + 4 * (ty & 1)) * 2) = w; }
            { u32x2 w; w.x = cvt_pk(ags[tyi][0], ags[tyi][1]); w.y = cvt_pk(ags[tyi][2], ags[tyi][3]); *(u32x2*)(gout + coff) = w; }
            st_row4(SL(3), x, y, awy[tyi]); st_row4(SL(1), x, y, aws[tyi]); } }
        __syncthreads();
        { if (d + 1 < dend) SA_DMA_LORA(h, d + 1); else { int tn, dn0, dn1; SA_UNIT(q + nblk, tn, dn0, dn1); if (tn >= 0) SA_DMA_LORA((tbeg + tn) / 260, dn0); } }
        { LDX(x3, 3); LDX(x7, 7); LDY(y7, 7); LDY(y8, 1);
          __builtin_amdgcn_sched_barrier(0);
          f32x4 ayl[2] = {zero, zero}, ahs[2] = {zero, zero};
          MM2(ayl, y7, x3); MM2(ahs, y8, x7);
#pragma unroll
          for (int tyi = 0; tyi < 2; ++tyi) { const int ty = ty0 + tyi, y = YOF(tyi);
            const size_t hoff = (size_t)((tx * 4 + ty) * 64 + lq) * 8;
            { u32x2 w; w.x = cvt_pk(ayl[tyi][0], ayl[tyi][1]); w.y = cvt_pk(ayl[tyi][2], ayl[tyi][3]); *(u32x2*)(gyout + 8192 + ((size_t)x * 64 + 16 * gq + 4 * ty) * 2) = w; }
            { u32x2 w; w.x = cvt_pk(ahs[tyi][0], ahs[tyi][1]); w.y = cvt_pk(ahs[tyi][2], ahs[tyi][3]); *(u32x2*)(gout + 8192 + hoff) = w; } } }
#undef FRX
#undef FRY
#undef MF
#undef LDX
#undef LDY
#undef MM2
#undef YOF
      }
    }
    __syncthreads();
}
__device__ __forceinline__ void ph_chain(const Params& P0, int b, int task, LAS unsigned char* lds) {
    const Params P = launder(P0);
    const int tid = opaque_tid(), lane = tid & 63, wid = __builtin_amdgcn_readfirstlane(tid >> 6), g = lane >> 4, v = lane & 15;
    const int hd = task >> 2, vb = task & 3;
    const unsigned char* base = P.ws + ((b == 1 && hd < 4) ? OFF_GH2 : OFF_GH) + (size_t)hd * 260 * 16384;
    bf16_t* Sg = (bf16_t*)(P.ws + OFF_XN) + ((size_t)(b * 16 + hd) * 260) * 4096 + (size_t)vb * 1024 + (size_t)lane * 8;
    constexpr int RS = 10240, NSLOT = 12, DEPTH = 8, FLG = NSLOT * RS;
    volatile LAS unsigned* fl = (volatile LAS unsigned*)(lds + FLG);
#define CH_ISSUE(n_) do { const unsigned char* cb_ = base + (size_t)(n_) * 16384; const int sl_ = (n_) % NSLOT; \
        _Pragma("unroll") for (int i_ = 0; i_ < 2; ++i_) { const int pc_ = 2 * (wid - 1) + i_; \
            const unsigned char* src_ = (pc_ < 8) ? cb_ + pc_ * 1024 : cb_ + 8192 + vb * 2048 + (pc_ - 8) * 1024; \
            __builtin_amdgcn_global_load_lds((const unsigned*)(src_ + lane * 16), (LAS unsigned*)(lds + sl_ * RS + pc_ * 1024), 16, 0, 0); } } while (0)
    const bool loader = (wid >= 1 && wid <= 5);
    if (tid < 8) fl[tid] = 0u;
    __builtin_amdgcn_s_barrier();
    if (loader) {
#pragma unroll 1
        for (int n = 0; n < 260; ++n) {
            if (n >= NSLOT) { unsigned spin = 0u; while (fl[0] + NSLOT <= (unsigned)n) { __builtin_amdgcn_s_sleep(1); if (++spin > (1u << 24)) break; } }
            asm volatile("" ::: "memory");
            CH_ISSUE(n);
            if (n >= DEPTH) { asm volatile("s_waitcnt vmcnt(16)" ::: "memory"); if (lane == 0) fl[wid] = (unsigned)(n - DEPTH + 1); }
        }
        asm volatile("s_waitcnt vmcnt(0)" ::: "memory");
        if (lane == 0) fl[wid] = 260u;
    } else if (wid == 0) {
        bf16x8 Sf[2]; Sf[0] = (bf16x8){0, 0, 0, 0, 0, 0, 0, 0}; Sf[1] = Sf[0];
        unsigned avail = 0u;
#pragma unroll 1
        for (int n = 0; n < 260; ++n) {
            if (avail <= (unsigned)n) { unsigned spin = 0u;
                for (;;) { avail = min(min(min(fl[1], fl[2]), min(fl[3], fl[4])), fl[5]); if (avail > (unsigned)n) break; __builtin_amdgcn_s_sleep(1); if (++spin > (1u << 24)) break; } }
            asm volatile("" ::: "memory");
            const LAS unsigned char* sl = lds + (n % NSLOT) * RS;
            bf16x8 gs[4][2]; u32x2 hs[4];
#pragma unroll
            for (int t = 0; t < 4; ++t) {
#pragma unroll
                for (int s2 = 0; s2 < 2; ++s2) gs[t][s2] = *(const LAS bf16x8*)(sl + ((t * 2 + s2) * 64 + lane) * 16);
                hs[t] = *(const LAS u32x2*)(sl + 8192 + (t * 64 + lane) * 8); }
            __builtin_amdgcn_sched_barrier(0);
            { const u32x4 w0 = __builtin_bit_cast(u32x4, Sf[0]), w1 = __builtin_bit_cast(u32x4, Sf[1]); bf16_t* sp = Sg + (size_t)n * 4096;
              *(u32x4*)(sp) = w0; *(u32x4*)(sp + 512) = w1; }
            f32x4 ns[4];
#pragma unroll
            for (int t = 0; t < 4; ++t) ns[t] = (f32x4){bf2f(hs[t].x & 0xffffu), bf2f(hs[t].x >> 16), bf2f(hs[t].y & 0xffffu), bf2f(hs[t].y >> 16)};
#pragma unroll
            for (int s2 = 0; s2 < 2; ++s2)
#pragma unroll
                for (int t = 0; t < 4; ++t) ns[t] = __builtin_amdgcn_mfma_f32_16x16x32_bf16(gs[t][s2], Sf[s2], ns[t], 0, 0, 0);
            { u32x4 w0, w1;
              w0.x = cvt_pk(ns[0][0], ns[0][1]); w0.y = cvt_pk(ns[0][2], ns[0][3]); w0.z = cvt_pk(ns[1][0], ns[1][1]); w0.w = cvt_pk(ns[1][2], ns[1][3]);
              w1.x = cvt_pk(ns[2][0], ns[2][1]); w1.y = cvt_pk(ns[2][2], ns[2][3]); w1.z = cvt_pk(ns[3][0], ns[3][1]); w1.w = cvt_pk(ns[3][2], ns[3][3]);
              Sf[0] = __builtin_bit_cast(bf16x8, w0); Sf[1] = __builtin_bit_cast(bf16x8, w1); }
            asm volatile("s_waitcnt lgkmcnt(0)" ::: "memory");
            if (lane == 0) fl[0] = (unsigned)(n + 1);
        }
    }
    __builtin_amdgcn_s_barrier();
    asm volatile("s_waitcnt vmcnt(0)" ::: "memory");
#undef CH_ISSUE
}
__device__ __forceinline__ void ph_pool_task(const Params& P0, int task, unsigned char* smem) {
    const Params P = launder(P0);
    const int tid = opaque_tid();
    const bf16_t* p = (const bf16_t*)(P.ws + OFF_P); bf16_t* mix = (bf16_t*)(P.ws + OFF_MIX);
    if (task < 512) {
        const int b = task >> 8, rr = task & 255, x = tid >> 3, cq = tid & 7;
        float* vs = (float*)smem;
#pragma unroll
        for (int gi = 0; gi < 4; ++gi) { const int half = 1 << gi, c = gi * 64 + cq * 8; const int rlo = max(rr - half, 0), rhi = min(rr + half, 256);
            float a[8] = {0.f, 0.f, 0.f, 0.f, 0.f, 0.f, 0.f, 0.f};
            bf16x8 xr[16];
#pragma unroll
            for (int k = 0; k < 2 * half; ++k) { const int r2 = min(max(rr - half + k, 0), 255); xr[k] = *(const bf16x8*)(p + (size_t)(b * T + r2 * 64 + x) * INC + 1792 + c); }
#pragma unroll
            for (int k = 0; k < 2 * half; ++k) { const int r2 = rr - half + k; const float m = (r2 >= rlo && r2 < rhi) ? 1.0f : 0.0f; float xf[8]; unpack8(xr[k], xf);
#pragma unroll
                for (int j = 0; j < 8; ++j) a[j] += xf[j] * m; }
            *(f32x4*)(vs + x * 260 + c) = (f32x4){a[0], a[1], a[2], a[3]}; *(f32x4*)(vs + x * 260 + c + 4) = (f32x4){a[4], a[5], a[6], a[7]}; }
        __syncthreads();
#pragma unroll
        for (int gi = 0; gi < 4; ++gi) { const int half = 1 << gi, c = gi * 64 + cq * 8; const int rlo = max(rr - half, 0), rhi = min(rr + half, 256), clo = max(x - half, 0), chi = min(x + half, 64);
            float a[8] = {0.f, 0.f, 0.f, 0.f, 0.f, 0.f, 0.f, 0.f};
            for (int x2 = clo; x2 < chi; ++x2) { const f32x4 v0 = *(const f32x4*)(vs + x2 * 260 + c), v1 = *(const f32x4*)(vs + x2 * 260 + c + 4);
#pragma unroll
                for (int j = 0; j < 4; ++j) { a[j] += v0[j]; a[4 + j] += v1[j]; } }
            const float icnt = 1.0f / (float)((rhi - rlo) * (chi - clo)); const size_t tok = (size_t)b * T + rr * 64 + x;
            float self[8]; unpack8(*(const bf16x8*)(p + tok * INC + 1792 + c), self);
#pragma unroll
            for (int j = 0; j < 8; ++j) a[j] = a[j] * icnt - self[j];
            *(bf16x8*)(mix + tok * MIXK + 512 + c) = pack8(a); }
        __syncthreads();
    } else {
        const int b = task - 512;
        for (int it = tid; it < 256 * 32; it += NT) { const int t = it >> 5, c = (it & 31) * 8, half = 1 << (c >> 6); const int lo = max(t - half, 0), hi = min(t + half, 256);
            float a[8] = {0.f, 0.f, 0.f, 0.f, 0.f, 0.f, 0.f, 0.f};
            bf16x8 xr[16];
#pragma unroll
            for (int k = 0; k < 16; ++k) { const int t2 = min(max(t - half + k, 0), 255); xr[k] = *(const bf16x8*)(p + (size_t)(LAT + b * TC + t2) * INC + 1792 + c); }
#pragma unroll
            for (int k = 0; k < 16; ++k) { const int t2 = t - half + k; const float m = (k < 2 * half && t2 >= lo && t2 < hi) ? 1.0f : 0.0f; float xf[8]; unpack8(xr[k], xf);
#pragma unroll
                for (int j = 0; j < 8; ++j) a[j] += xf[j] * m; }
            const float icnt = 1.0f / (float)(hi - lo); const size_t tok = (size_t)LAT + b * TC + t;
            float self[8]; unpack8(*(const bf16x8*)(p + tok * INC + 1792 + c), self);
#pragma unroll
            for (int j = 0; j < 8; ++j) a[j] = a[j] * icnt - self[j];
            *(bf16x8*)(mix + tok * MIXK + 512 + c) = pack8(a); }
    }
}
template <int K>
__device__ __forceinline__ void dft_task(const bf16_t* Xmat, const bf16_t* src, size_t sstride, unsigned char* smem, int mode, int b, int idx, bf16_t* Y1, bf16_t* mix) {
    constexpr int ldu = K + 8;
    const int tid = opaque_tid(), lane = tid & 63, wid = tid >> 6, r = lane & 15, g = lane >> 4;
#pragma unroll 1
    for (int it0 = tid; it0 < K * 64; it0 += 8 * NT) { u32x2 sv[8];
#pragma unroll
        for (int q = 0; q < 8; ++q) { const int it = it0 + q * NT, blk = it >> 6, l6 = it & 63, kk = (blk % (K / 16)) * 16 + (l6 & 15), c0 = ((blk / (K / 16)) * 4 + (l6 >> 4)) * 4; sv[q] = *(const u32x2*)(src + (size_t)kk * sstride + c0); }
#pragma unroll
        for (int q = 0; q < 8; ++q) { const int it = it0 + q * NT, blk = it >> 6, l6 = it & 63, kk = (blk % (K / 16)) * 16 + (l6 & 15), c0 = ((blk / (K / 16)) * 4 + (l6 >> 4)) * 4;
            *(bf16_t*)(smem + ((size_t)(c0 + 0) * ldu + kk) * 2) = (bf16_t)(sv[q].x & 0xffffu); *(bf16_t*)(smem + ((size_t)(c0 + 1) * ldu + kk) * 2) = (bf16_t)(sv[q].x >> 16);
            *(bf16_t*)(smem + ((size_t)(c0 + 2) * ldu + kk) * 2) = (bf16_t)(sv[q].y & 0xffffu); *(bf16_t*)(smem + ((size_t)(c0 + 3) * ldu + kk) * 2) = (bf16_t)(sv[q].y >> 16); } }
    bf16x8 xf[2][K / 32];
#pragma unroll
    for (int mt = 0; mt < 2; ++mt)
#pragma unroll
        for (int ks = 0; ks < K / 32; ++ks) xf[mt][ks] = *(const bf16x8*)(Xmat + (size_t)(16 * (2 * wid + mt) + r) * K + 32 * ks + 8 * g);
    __syncthreads();
    for (int ct = 0; ct < 16; ++ct) {
        f32x4 acc[2] = {{0.f, 0.f, 0.f, 0.f}, {0.f, 0.f, 0.f, 0.f}};
#pragma unroll
        for (int ks = 0; ks < K / 32; ++ks) { const bf16x8 yf = *(const bf16x8*)(smem + ((size_t)(16 * ct + r) * ldu + 32 * ks + 8 * g) * 2);
            acc[0] = __builtin_amdgcn_mfma_f32_16x16x32_bf16(yf, xf[0][ks], acc[0], 0, 0, 0); acc[1] = __builtin_amdgcn_mfma_f32_16x16x32_bf16(yf, xf[1][ks], acc[1], 0, 0, 0); }
#pragma unroll
        for (int mt = 0; mt < 2; ++mt) { const int m = 16 * (2 * wid + mt) + r, c = 16 * ct + 4 * g;
            u32x2 w; w.x = cvt_pk(acc[mt][0], acc[mt][1]); w.y = cvt_pk(acc[mt][2], acc[mt][3]);
            if (mode == 0) { const int reim = m >> 7, k1 = m & 127; *(u32x2*)(Y1 + ((size_t)(((b * 128 + k1) * 2 + reim) * 128 + idx)) * 256 + c) = w; }
            else { int reim, tok; if (mode == 1) { reim = m >> 7; tok = b * T + idx + 128 * (m & 127); } else { const int m2 = idx * 256 + m; reim = m2 >> 8; tok = LAT + b * TC + (m2 & 255); }
                *(u32x2*)(mix + (size_t)tok * MIXK + 768 + (c >> 6) * 128 + reim * 64 + (c & 63)) = w; } }
    }
    __syncthreads();
}
__device__ __forceinline__ void ph_readout(const Params& P0, int l, unsigned char* smem, int bid, int nblk, int rp) {
    const Params P = launder(P0);
    const int tid = opaque_tid(), lane = tid & 63, h = tid >> 6, r = lane & 15, g = lane >> 4;
    const bf16_t* p = (const bf16_t*)(P.ws + OFF_P); bf16_t* mix = (bf16_t*)(P.ws + OFF_MIX);
    const float* bonus = (const float*)(P.ws + OFF_BONUS);
    const float* sw = P.in[9] + (size_t)l * 3 * 1792;
    const bf16_t* gupT = (const bf16_t*)(P.ws + OFF_GUPT) + (size_t)l * 512 * 128;
    unsigned char* gwl = smem + 16384 + h * 16384;
    { bf16x8 gw[16];
#pragma unroll
      for (int q = 0; q < 16; ++q) { const int row = 4 * q + (lane >> 4), ch = lane & 15; gw[q] = *(const bf16x8*)(gupT + (size_t)(h * 64 + row) * 128 + 8 * ch); }
      __builtin_amdgcn_sched_barrier(0);
#pragma unroll
      for (int q = 0; q < 16; ++q) { const int row = 4 * q + (lane >> 4), ch = lane & 15; *(bf16x8*)(gwl + row * 256 + ((ch ^ (row & 15)) << 4)) = gw[q]; } }
    float* swl = (float*)(smem + 8704) + h * 192;
#pragma unroll
    for (int dt = 0; dt < 3; ++dt) swl[dt * 64 + lane] = sw[dt * 1792 + 1024 + h * 64 + lane];
    const int nlat2 = (LAT / 64) * 2, ntask = nlat2 + ((l == 0) ? (MT - LAT) / 64 * 2 : 0);
    const int npre = min(128 + 3 * max(nblk - 128, 0), nlat2 / 2), nrem = nlat2 - npre, per = (nrem + nblk - 1) / nblk;
    const int nit = rp ? per + 1 : 3;
    for (int it = 0; it < nit; ++it) {
        int tk;
        if (rp == 0) { if (bid < 128) { if (it >= 2) continue; tk = (bid - 64) * 2 + it; } else tk = 128 + (bid - 128) * 3 + it;
            if (tk >= npre) continue; }
        else if (it < per) { const int rr = bid * per + it; if (rr >= nrem) continue; tk = npre + rr; }
        else { tk = nlat2 + bid; if (tk >= ntask) continue; }
        const int tile = tk >> 1, tx2 = tk & 1, tok0 = tile * 64;
        int lo, hi; if (tok0 < LAT) { lo = (tok0 / T) * T; hi = lo + T; } else { lo = LAT + ((tok0 - LAT) / TC) * TC; hi = lo + TC; }
        int bb, jj; if (tok0 < LAT) { bb = tok0 / T; jj = 4 + (tok0 - bb * T) / 64; } else { bb = (tok0 - LAT) / TC; jj = ((tok0 - LAT) % TC) / 64; }
        const int n0 = jj, n1 = (jj < 4) ? 3 - jj : 263 - jj;
        const bf16_t* gy0 = (const bf16_t*)(P.ws + OFF_GY + (size_t)(((bb * 8 + h) * 2 + 0) * 260 + n0) * 16384);
        const bf16_t* gy1 = (const bf16_t*)(P.ws + OFF_GY + (size_t)(((bb * 8 + h) * 2 + 1) * 260 + n1) * 16384);
        const bf16_t* st0 = (const bf16_t*)(P.ws + OFF_XN) + ((size_t)((bb * 8 + h) * 2 + 0) * 260 + n0) * 4096;
        const bf16_t* st1 = (const bf16_t*)(P.ws + OFF_XN) + ((size_t)((bb * 8 + h) * 2 + 1) * 260 + n1) * 4096;
        const int tb = 32 * tx2 + r;
        const int tl = tid >> 5, c4 = (tid & 31) * 4;
        f32x4 ug[2];
#pragma unroll
        for (int u = 0; u < 2; ++u) ug[u] = conv4(p, sw, tok0 + 32 * tx2 + 16 * u + tl, lo, hi, 1664 + c4);
        bf16x8 x0[2][2], x1[2][2], s0[2][4], s1v[2][4];
#pragma unroll
        for (int u = 0; u < 2; ++u)
#pragma unroll
            for (int ks = 0; ks < 2; ++ks) { x0[u][ks] = *(const bf16x8*)(gy0 + (tb + 16 * u) * 64 + 32 * ks + 8 * g); x1[u][ks] = *(const bf16x8*)(gy1 + (63 - tb - 16 * u) * 64 + 32 * ks + 8 * g); }
#pragma unroll
        for (int ks = 0; ks < 2; ++ks)
#pragma unroll
            for (int cy = 0; cy < 4; ++cy) { s0[ks][cy] = *(const bf16x8*)(st0 + cy * 1024 + ks * 512 + lane * 8); s1v[ks][cy] = *(const bf16x8*)(st1 + cy * 1024 + ks * 512 + lane * 8); }
#pragma unroll
        for (int u = 0; u < 2; ++u) { u32x2 w; w.x = cvt_pk(sigmoidf_(ug[u][0]), sigmoidf_(ug[u][1])); w.y = cvt_pk(sigmoidf_(ug[u][2]), sigmoidf_(ug[u][3]));
          *(u32x2*)(smem + ((size_t)(tl + 16 * u) * 136 + c4) * 2) = w; }
        __syncthreads();
        f32x4 ys[2][4];
#pragma unroll
        for (int u = 0; u < 2; ++u)
#pragma unroll
            for (int cy = 0; cy < 4; ++cy) ys[u][cy] = (f32x4){0.f, 0.f, 0.f, 0.f};
#pragma unroll
        for (int ks = 0; ks < 2; ++ks)
#pragma unroll
            for (int cy = 0; cy < 4; ++cy)
#pragma unroll
                for (int u = 0; u < 2; ++u) { ys[u][cy] = __builtin_amdgcn_mfma_f32_16x16x32_bf16(s0[ks][cy], x0[u][ks], ys[u][cy], 0, 0, 0); ys[u][cy] = __builtin_amdgcn_mfma_f32_16x16x32_bf16(s1v[ks][cy], x1[u][ks], ys[u][cy], 0, 0, 0); }
        __builtin_amdgcn_sched_barrier(0);
#pragma unroll 1
        for (int u = 0; u < 2; ++u) {
            const int t = tb + 16 * u, tok = tok0 + t;
            u32x2 yl0[4], yl1[4]; f32x4 vv[4];
            { const u32x4 a0 = *(const u32x4*)(gy0 + 4096 + t * 64 + 16 * g), a1 = *(const u32x4*)(gy0 + 4096 + t * 64 + 16 * g + 8), b0 = *(const u32x4*)(gy1 + 4096 + (63 - t) * 64 + 16 * g), b1 = *(const u32x4*)(gy1 + 4096 + (63 - t) * 64 + 16 * g + 8);
              yl0[0] = (u32x2){a0.x, a0.y}; yl0[1] = (u32x2){a0.z, a0.w}; yl0[2] = (u32x2){a1.x, a1.y}; yl0[3] = (u32x2){a1.z, a1.w};
              yl1[0] = (u32x2){b0.x, b0.y}; yl1[1] = (u32x2){b0.z, b0.w}; yl1[2] = (u32x2){b1.x, b1.y}; yl1[3] = (u32x2){b1.z, b1.w}; }
#pragma unroll
            for (int cy = 0; cy < 4; ++cy) vv[cy] = conv4l(p, swl + 16 * cy + 4 * g, tok, lo, hi, 1024 + h * 64 + 16 * cy + 4 * g);
            const float bon = bonus[(size_t)tok * 8 + h] + bonus[((size_t)MT + tok) * 8 + h];
            f32x4 gt[4];
            float s1 = 0.f;
#pragma unroll
            for (int hf = 0; hf < 2; ++hf) {
                bf16x8 gfr[2][4];
#pragma unroll
                for (int c2 = 0; c2 < 2; ++c2)
#pragma unroll
                    for (int ks = 0; ks < 4; ++ks) { const int row = 16 * (2 * hf + c2) + r; gfr[c2][ks] = *(const bf16x8*)(gwl + row * 256 + (((4 * ks + g) ^ (row & 15)) << 4)); }
#pragma unroll
                for (int c2 = 0; c2 < 2; ++c2) { const int cy = 2 * hf + c2; f32x4 a = {0.f, 0.f, 0.f, 0.f};
#pragma unroll
                    for (int ks = 0; ks < 4; ++ks) { const bf16x8 xfr = *(const bf16x8*)(smem + ((size_t)(16 * u + r) * 136 + 32 * ks + 8 * g) * 2);
                        a = __builtin_amdgcn_mfma_f32_16x16x32_bf16(gfr[c2][ks], xfr, a, 0, 0, 0); }
                    gt[cy] = a; }
                __builtin_amdgcn_sched_barrier(0); }
#pragma unroll
            for (int cy = 0; cy < 4; ++cy) {
                ys[0][cy] = ys[0][cy] + (f32x4){bf2f(yl0[cy].x & 0xffffu) + bf2f(yl1[cy].x & 0xffffu), bf2f(yl0[cy].x >> 16) + bf2f(yl1[cy].x >> 16), bf2f(yl0[cy].y & 0xffffu) + bf2f(yl1[cy].y & 0xffffu), bf2f(yl0[cy].y >> 16) + bf2f(yl1[cy].y >> 16)};
                s1 += (ys[0][cy][0] + ys[0][cy][1]) + (ys[0][cy][2] + ys[0][cy][3]); }
            s1 += sx<16>(s1, lane); s1 += sx<32>(s1, lane);
            const float mu = s1 * (1.0f / 64.0f); float s2 = 0.f;
#pragma unroll
            for (int cy = 0; cy < 4; ++cy)
#pragma unroll
                for (int j = 0; j < 4; ++j) { const float dd = ys[0][cy][j] - mu; s2 += dd * dd; }
            s2 += sx<16>(s2, lane); s2 += sx<32>(s2, lane);
            const float rstd = rsqrtf(s2 * (1.0f / 64.0f) + 64e-5f);
#pragma unroll
            for (int cy = 0; cy < 4; ++cy) { const int hc = h * 64 + 16 * cy + 4 * g;
                f32x4 o;
                const f32x4 lgv = *(const f32x4*)(P.in[18] + l * 512 + hc), lbv = *(const f32x4*)(P.in[19] + l * 512 + hc);
#pragma unroll
                for (int j = 0; j < 4; ++j) o[j] = ((ys[0][cy][j] - mu) * rstd * lgv[j] + lbv[j] + bon * vv[cy][j]) * gt[cy][j];
                u32x2 w; w.x = cvt_pk(o[0], o[1]); w.y = cvt_pk(o[2], o[3]); *(u32x2*)(mix + (size_t)tok * MIXK + hc) = w; }
#pragma unroll
            for (int cy = 0; cy < 4; ++cy) ys[0][cy] = ys[1][cy];
        }
        __syncthreads();
    }
}
__device__ __forceinline__ void ph_norm2(const Params& P0, int l, unsigned char* smem, int bid, int nblk) {
    const Params P = launder(P0);
    const int tid = opaque_tid(), lane = tid & 63, gw = bid * 8 + (tid >> 6), ngw = nblk * 8;
    float* RW = (float*)smem;
    for (int i = tid; i < 16384; i += NT) RW[(i & 15) * 1024 + (i >> 4)] = P.in[24][(size_t)l * 16384 + i];
    float* GM = (float*)(smem + 65536); float* SHV = GM + 3072;
    for (int i = tid; i < 3072; i += NT) { const int s_ = i >> 10, c_ = i & 1023; const float* sh_ = (const float*)(P.ws + OFF_MODS) + (size_t)(l * 3 + s_) * 6144 + 3072;
        GM[i] = P.in[7][l * D + c_] * (sh_[1024 + c_] + 1.0f); SHV[i] = sh_[c_]; }
    __syncthreads();
    const float* mods = (const float*)(P.ws + OFF_MODS); const float* hctx = (const float*)(P.ws + OFF_HCTX);
    bf16_t* h2 = (bf16_t*)(P.ws + OFF_XN); float* aff = (float*)(P.ws + OFF_AFF); float* affc = (float*)(P.ws + OFF_AFFC);
    const float* gn = P.in[7] + l * D;
    const int nrows = (l == 0) ? MT : LAT;
    for (int pr = gw; pr < nrows / 2; pr += ngw) {
        const int rr = 2 * pr;
        const int s = (rr < LAT) ? rr / T : 2;
        const float* hrow = (rr < LAT) ? P.out + (size_t)rr * D : hctx + (size_t)(rr - LAT) * D;
        if (l == 0 && rr >= LAT) {
            float* hw = (float*)(P.ws + OFF_HCTX) + (size_t)(rr - LAT) * D; const float* slab = (const float*)(P.ws + OFF_SLAB); const float* g1 = mods + (size_t)2 * 6144 + 2048;
#pragma unroll
            for (int q = 0; q < 2; ++q) { f32x4 sv[4][5], hv[4], gv[4];
#pragma unroll
                for (int i = 0; i < 4; ++i) { const int c = 4 * lane + 256 * i;
#pragma unroll
                    for (int ks = 0; ks < 5; ++ks) sv[i][ks] = *(const f32x4*)(slab + ((size_t)ks * 512 + (rr - LAT + q)) * D + c);
                    hv[i] = *(const f32x4*)(hw + q * D + c); gv[i] = *(const f32x4*)(g1 + c); }
                __builtin_amdgcn_sched_barrier(0);
#pragma unroll
                for (int i = 0; i < 4; ++i) { const int c = 4 * lane + 256 * i;
                    *(f32x4*)(hw + q * D + c) = hv[i] + gv[i] * ((((sv[i][0] + sv[i][1]) + sv[i][2]) + sv[i][3]) + sv[i][4]); }
                __builtin_amdgcn_sched_barrier(0); }
            asm volatile("s_waitcnt vmcnt(0)" ::: "memory"); __builtin_amdgcn_fence(__ATOMIC_ACQUIRE, "agent"); asm volatile("s_waitcnt vmcnt(0)" ::: "memory"); }
        f32x4 v[2][4]; float ss[2] = {0.f, 0.f};
#pragma unroll
        for (int q = 0; q < 2; ++q)
#pragma unroll
            for (int i = 0; i < 4; ++i) { v[q][i] = *(const f32x4*)(hrow + q * D + 4 * lane + 256 * i); ss[q] += (v[q][i][0] * v[q][i][0] + v[q][i][1] * v[q][i][1]) + (v[q][i][2] * v[q][i][2] + v[q][i][3] * v[q][i][3]); }
        float rs[2];
#pragma unroll
        for (int q = 0; q < 2; ++q) rs[q] = rsqrtf(wave_sum(ss[q], lane) * (1.0f / D) + 1e-6f);
        const float* sh = mods + (size_t)(l * 3 + s) * 6144 + 3072, *sc = sh + 1024;
        float lg[2][16];
#pragma unroll
        for (int q = 0; q < 2; ++q)
#pragma unroll
            for (int e = 0; e < 16; ++e) lg[q][e] = 0.f;
#pragma unroll 1
        for (int i = 0; i < 4; ++i) { const int c = 4 * lane + 256 * i;
            const f32x4 gm = *(const f32x4*)(GM + s * 1024 + c), shv = *(const f32x4*)(SHV + s * 1024 + c);
            f32x4 y[2];
#pragma unroll
            for (int q = 0; q < 2; ++q) { y[q] = v[q][0] * rs[q] * gm + shv; v[q][0] = v[q][1]; v[q][1] = v[q][2]; v[q][2] = v[q][3];
                u32x2 w; w.x = cvt_pk(y[q][0], y[q][1]); w.y = cvt_pk(y[q][2], y[q][3]); *(u32x2*)(h2 + (size_t)(rr + q) * D + c) = w; }
#pragma unroll
            for (int e = 0; e < 16; ++e) { const f32x4 wv = *(const f32x4*)(RW + e * 1024 + c);
#pragma unroll
                for (int q = 0; q < 2; ++q) lg[q][e] += (y[q][0] * wv[0] + y[q][1] * wv[1]) + (y[q][2] * wv[2] + y[q][3] * wv[3]); }
            }
#pragma unroll
        for (int q = 0; q < 2; ++q) {
        float a8[8], a4[4], a2[2], a1;
        { const bool up = (lane & 32) != 0;
#pragma unroll
          for (int k = 0; k < 8; ++k) { const float keep = up ? lg[q][8 + k] : lg[q][k], send = up ? lg[q][k] : lg[q][8 + k]; a8[k] = keep + sx<32>(send, lane); } }
        { const bool up = (lane & 16) != 0;
#pragma unroll
          for (int k = 0; k < 4; ++k) { const float keep = up ? a8[4 + k] : a8[k], send = up ? a8[k] : a8[4 + k]; a4[k] = keep + sx<16>(send, lane); } }
        { const bool up = (lane & 8) != 0;
#pragma unroll
          for (int k = 0; k < 2; ++k) { const float keep = up ? a4[2 + k] : a4[k], send = up ? a4[k] : a4[2 + k]; a2[k] = keep + sx<8>(send, lane); } }
        { const bool up = (lane & 4) != 0; const float keep = up ? a2[1] : a2[0], send = up ? a2[0] : a2[1]; a1 = keep + sx<4>(send, lane); }
        a1 += sx<1>(a1, lane); a1 += sx<2>(a1, lane);
        float mx = a1;
        mx = fmaxf(mx, sx<4>(mx, lane)); mx = fmaxf(mx, sx<8>(mx, lane)); mx = fmaxf(mx, sx<16>(mx, lane)); mx = fmaxf(mx, sx<32>(mx, lane));
        const float ex = __expf(a1 - mx); float sm = ex;
        sm += sx<4>(sm, lane); sm += sx<8>(sm, lane); sm += sx<16>(sm, lane); sm += sx<32>(sm, lane);
        const int r1 = rr + q;
        if ((lane & 3) == 0) { const int e = ((lane >> 5) & 1) * 8 + ((lane >> 4) & 1) * 4 + ((lane >> 3) & 1) * 2 + ((lane >> 2) & 1); const float a = ex / sm;
            if (r1 < LAT) aff[(size_t)((r1 / T) * 16 + e) * T + (r1 % T)] = a; else affc[(size_t)(((r1 - LAT) / TC) * 16 + e) * TC + ((r1 - LAT) % TC)] = a; }
        }
    }
    __syncthreads();
}
__device__ __forceinline__ void ph_topk_task(const Params& P0, int pid, unsigned char* smem) {
    const Params P = launder(P0);
    const int tid = opaque_tid(), lane = tid & 63, wid = tid >> 6;
    int* idx = (int*)(P.ws + OFF_IDX); float* gate = (float*)(P.ws + OFF_GATE); int* inv = (int*)(P.ws + OFF_INV);
    unsigned* hist = (unsigned*)smem;
    unsigned* sh = (unsigned*)(smem + 1024);
    if (pid < 32) {
        const int b = pid >> 4, e = pid & 15;
        const float* a = (const float*)(P.ws + OFF_AFF) + (size_t)pid * T + tid * 32;
        unsigned key[32];
#pragma unroll
        for (int i = 0; i < 8; ++i) { const f32x4 v = *(const f32x4*)(a + 4 * i); key[4 * i] = __float_as_uint(v[0]); key[4 * i + 1] = __float_as_uint(v[1]); key[4 * i + 2] = __float_as_uint(v[2]); key[4 * i + 3] = __float_as_uint(v[3]); }
        unsigned prefix = 0u, need = CAP;
        for (int pass = 3; pass >= 0; --pass) {
            const int shf = pass * 8;
            if (tid < 256) hist[tid] = 0u;
            __syncthreads();
            const unsigned himask = (pass == 3) ? 0u : (0xffffffffu << (shf + 8));
            if (pass == 3) {
                const unsigned b0 = key[0] >> 24; unsigned c0 = 0u;
#pragma unroll
                for (int i = 0; i < 32; ++i) c0 += ((key[i] >> 24) == b0) ? 1u : 0u;
                atomicAdd(&hist[b0], c0);
                if (c0 != 32u) {
#pragma unroll
                    for (int i = 0; i < 32; ++i) if ((key[i] >> 24) != b0) atomicAdd(&hist[key[i] >> 24], 1u); }
            } else {
#pragma unroll
                for (int i = 0; i < 32; ++i) if ((key[i] & himask) == (prefix & himask)) atomicAdd(&hist[(key[i] >> shf) & 255u], 1u); }
            __syncthreads();
            unsigned hb = 0u, suf = 0u;
            if (tid < 256) { hb = hist[tid]; suf = hb;
#pragma unroll
                for (int o = 1; o < 64; o <<= 1) { const unsigned t2 = (unsigned)__builtin_amdgcn_ds_bpermute(((lane + o) & 63) << 2, (int)suf); if (lane + o < 64) suf += t2; }
                if (lane == 0) sh[4 + wid] = suf; }
            __syncthreads();
            if (tid < 256) { for (int w2 = wid + 1; w2 < 4; ++w2) suf += sh[4 + w2];
                if (suf >= need && suf - hb < need) { sh[0] = prefix | ((unsigned)tid << shf); sh[1] = need - (suf - hb); } }
            __syncthreads();
            prefix = sh[0]; need = sh[1];
            __syncthreads();
        }
        unsigned neq = 0u, ngt = 0u;
#pragma unroll
        for (int i = 0; i < 32; ++i) { neq += (key[i] == prefix); ngt += (key[i] > prefix); }
        unsigned eq_incl = neq;
#pragma unroll
        for (int o = 1; o < 64; o <<= 1) { const unsigned t2 = (unsigned)__builtin_amdgcn_ds_bpermute(((lane - o) & 63) << 2, (int)eq_incl); if (lane >= o) eq_incl += t2; }
        if (lane == 63) sh[8 + wid] = eq_incl;
        __syncthreads();
        unsigned eq_off = eq_incl - neq;
        for (int w2 = 0; w2 < wid; ++w2) eq_off += sh[8 + w2];
        unsigned nsel = ngt, er = eq_off;
#pragma unroll
        for (int i = 0; i < 32; ++i) if (key[i] == prefix) { nsel += (er < need); ++er; }
        unsigned sel_incl = nsel;
#pragma unroll
        for (int o = 1; o < 64; o <<= 1) { const unsigned t2 = (unsigned)__builtin_amdgcn_ds_bpermute(((lane - o) & 63) << 2, (int)sel_incl); if (lane >= o) sel_incl += t2; }
        if (lane == 63) sh[16 + wid] = sel_incl;
        __syncthreads();
        unsigned slot = sel_incl - nsel;
        for (int w2 = 0; w2 < wid; ++w2) slot += sh[16 + w2];
        er = eq_off;
#pragma unroll
        for (int i = 0; i < 32; ++i) { const int t = tid * 32 + i; bool s = key[i] > prefix;
            if (key[i] == prefix) { s = (er < need); ++er; }
            const int tok = b * T + t;
            if (s) { idx[(size_t)pid * CAP + slot] = tok; gate[(size_t)pid * CAP + slot] = __uint_as_float(key[i]); inv[(size_t)tok * 16 + e] = (int)slot; ++slot; }
            else inv[(size_t)tok * 16 + e] = -1; }
        __syncthreads();
    } else {
        const int gidx = pid - 32, b = gidx >> 4, e = gidx & 15;
        float* vals = (float*)(smem + 2048);
        const float* a = (const float*)(P.ws + OFF_AFFC) + (size_t)gidx * TC;
        if (tid < 256) vals[tid] = a[tid];
        __syncthreads();
        if (tid < 256) { const float mv = vals[tid]; int rank = 0;
            for (int j = 0; j < 256; ++j) { const float o = vals[j]; rank += (o > mv) || (o == mv && j < tid); }
            const int tok = LAT + b * TC + tid;
            idx[65536 + (size_t)gidx * 256 + rank] = tok; gate[65536 + (size_t)gidx * 256 + rank] = (rank < CAPC) ? mv : 0.f;
            inv[(size_t)tok * 16 + e] = (rank < CAPC) ? rank : -1; }
        __syncthreads();
    }
}
__device__ __forceinline__ void ph_convw(const Params& P0, int l, unsigned char* smem, int t0, int t1) {
    const Params P = launder(P0);
    const int tid = opaque_tid();
    float* tile = (float*)smem;
    for (int t = t0; t < t1; ++t) { const int mat = t >> 6, rr = t & 63, tk = rr >> 2, tn4 = rr & 3, kind = mat >> 4, e = mat & 15;
        const float* src = (kind == 0 ? P.in[25] : (kind == 1 ? P.in[26] : P.in[27])) + (size_t)(l * 16 + e) * D * D;
        bf16_t* dst = (kind < 2) ? (bf16_t*)(P.ws + OFF_WGU) + (size_t)e * 2048 * D : (bf16_t*)(P.ws + OFF_WD) + (size_t)e * D * D;
        f32x4 v[8];
#pragma unroll
        for (int i = 0; i < 8; ++i) { const int eidx = tid + i * NT, kk = eidx >> 6, n4 = (eidx & 63) * 4; v[i] = *(const f32x4*)(src + (size_t)(tk * 64 + kk) * D + tn4 * 256 + n4); }
#pragma unroll
        for (int i = 0; i < 8; ++i) { const int eidx = tid + i * NT, kk = eidx >> 6, n4 = (eidx & 63) * 4; *(f32x4*)(tile + kk * 260 + n4) = v[i]; }
        __syncthreads();
        { const int n = tid >> 1, k0 = (tid & 1) * 32; const int ng = tn4 * 256 + n;
          int row = ng; if (kind == 0) row = (ng >> 7) * 256 + (ng & 127); else if (kind == 1) row = (ng >> 7) * 256 + 128 + (ng & 127);
#pragma unroll
          for (int c = 0; c < 4; ++c) { float o[8];
#pragma unroll
              for (int j = 0; j < 8; ++j) o[j] = tile[(k0 + 8 * c + j) * 260 + n];
              *(bf16x8*)(dst + (size_t)row * D + tk * 64 + k0 + 8 * c) = pack8(o); } }
        __syncthreads();
    }
}
__device__ __forceinline__ void ph_gather(const Params& P0, int l, int bid, int nblk) {
    const Params P = launder(P0);
    const int lane = opaque_tid() & 63, gw = bid * 8 + (opaque_tid() >> 6), ngw = nblk * 8;
    const int* idx = (const int*)(P.ws + OFF_IDX); const bf16_t* h2 = (const bf16_t*)(P.ws + OFF_XN); bf16_t* xe = (bf16_t*)(P.ws + OFF_XE);
    const int nrow = 65536 + ((l == 0) ? 32 * 32 : 0);
    for (int i0 = gw * 4; i0 < nrow; i0 += ngw * 4) {
        int row[4], tok[4]; u32x4 a[4], c[4];
#pragma unroll
        for (int q = 0; q < 4; ++q) { const int i = i0 + q; row[q] = (i < 65536) ? i : 65536 + ((i - 65536) >> 5) * 256 + ((i - 65536) & 31); tok[q] = idx[row[q]]; }
#pragma unroll
        for (int q = 0; q < 4; ++q) { a[q] = *(const u32x4*)(h2 + (size_t)tok[q] * D + lane * 8); c[q] = *(const u32x4*)(h2 + (size_t)tok[q] * D + 512 + lane * 8); }
#pragma unroll
        for (int q = 0; q < 4; ++q) { *(u32x4*)(xe + (size_t)row[q] * D + lane * 8) = a[q]; *(u32x4*)(xe + (size_t)row[q] * D + 512 + lane * 8) = c[q]; }
    }
}

__device__ __forceinline__ void ph_moe2_ctx(const Params& P0, int bid, int nblk) {
    const Params P = launder(P0);
    const int tid = opaque_tid(), lane = tid & 63, wid = tid >> 6, r = lane & 15, g = lane >> 4;
    const bf16_t* hid = (const bf16_t*)(P.ws + OFF_HID); const bf16_t* wd = (const bf16_t*)(P.ws + OFF_WD);
    bf16_t* ye = (bf16_t*)(P.ws + OFF_XE); const float* gate = (const float*)(P.ws + OFF_GATE);
    const int mt = wid & 3, np = wid >> 2;
    for (int item = bid; item < 256; item += nblk) {
        const int e = item >> 4, nc = item & 15;
        const int row = 65536 + ((mt >> 1) * 16 + e) * 256 + 16 * (mt & 1) + r;
        const int n0 = nc * 64 + np * 32;
        const bf16_t* ap = hid + (size_t)row * D + 8 * g;
        const bf16_t* bp = wd + ((size_t)e * D + n0 + r) * D + 8 * g;
        const float gs = gate[row];
        f32x4 acc0 = {0.f, 0.f, 0.f, 0.f}, acc1 = acc0;
#pragma unroll 8
        for (int ks = 0; ks < 32; ++ks) { const bf16x8 a = *(const bf16x8*)(ap + 32 * ks), b0 = *(const bf16x8*)(bp + 32 * ks), b1 = *(const bf16x8*)(bp + (size_t)16 * D + 32 * ks);
            acc0 = __builtin_amdgcn_mfma_f32_16x16x32_bf16(b0, a, acc0, 0, 0, 0); acc1 = __builtin_amdgcn_mfma_f32_16x16x32_bf16(b1, a, acc1, 0, 0, 0); }
        { u32x2 w; w.x = cvt_pk(acc0[0] * gs, acc0[1] * gs); w.y = cvt_pk(acc0[2] * gs, acc0[3] * gs); *(u32x2*)(ye + (size_t)row * D + n0 + 4 * g) = w; }
        { u32x2 w; w.x = cvt_pk(acc1[0] * gs, acc1[1] * gs); w.y = cvt_pk(acc1[2] * gs, acc1[3] * gs); *(u32x2*)(ye + (size_t)row * D + n0 + 16 + 4 * g) = w; }
    }
}

__global__ void __launch_bounds__(NT, 2) hybrid_fwd(Params PK) {
    extern __shared__ __attribute__((aligned(16))) unsigned char smem[];
    const int tid = opaque_tid(), G = gridDim.x, bid = blockIdx.x;
    LAS unsigned char* lds = (LAS unsigned char*)smem;
    if (tid < 64) ((volatile LAS unsigned*)(lds + LDS_MISC))[tid] = 0u;
    __syncthreads();
    (void)xcd_barrier_post((unsigned*)(PK.ws + OFF_CTL), (volatile LAS unsigned*)(lds + LDS_MISC));
    if (PROF_A >= 0 && bid == 0 && tid == 0) ((unsigned long long*)(PK.ws + OFF_CTL + 15360))[0] = __builtin_amdgcn_s_memrealtime();
#define GRID_SYNC(K_) do { size_t zb_ = 0; asm volatile("" : "+s"(zb_)); unsigned* bp_ = (unsigned*)(PK.ws + OFF_CTL + zb_); XcdBarrier bar_; bar_.bar = bp_; bar_.x = xb_xcc_id(); bar_.st = (volatile LAS unsigned*)(lds + LDS_MISC); xcd_barrier(bar_); \
        if (PROF_A >= 0) { if (bid == 0 && opaque_tid() == 0) ((unsigned long long*)(bp_ + 3840))[(K_)] = __builtin_amdgcn_s_memrealtime(); } \
        if (STOP_AFTER > 0 && (K_) >= STOP_AFTER) { if (DUMP_OFF) { const unsigned* srcw = (const unsigned*)(PK.ws + (size_t)DUMP_OFF); const int t3_ = opaque_tid(); for (size_t i = (size_t)bid * NT + t3_; i < (size_t)DUMP_WORDS; i += (size_t)G * NT) PK.out[i] = (float)(srcw[i] & 0xffffffu); } return; } } while (0)

    if (EN(0)) ph_mods(PK, smem, bid, G);
    GRID_SYNC(1);
    { const int nprep = (G > 2 * NPREP) ? NPREP : G / 2, nnorm = G - nprep;
      if (bid < nnorm) { if (EN(1)) ph_norm1(PK, 0, smem, bid, nnorm); }
      else if (EN(0)) { const int vb = bid - nnorm; ph_fold(PK, smem, vb, nprep); ph_prep_weights(PK, smem, vb, nprep); ph_tables(PK, vb, nprep); } }
    GRID_SYNC(2);

#pragma unroll 1
    for (int l = 0; l < 2; ++l) {
        const int sb = l ? 15 : 2;
        if (EN(1)) if (l > 0) { ph_norm1(PK, 1, smem, bid, G); GRID_SYNC(15); }
        if (EN(2)) { const Params P = launder(PK); pg8::SchedDense S; S.init(MT, INC, D, G, bid, P.ws + OFF_XN, P.ws + OFF_WINT + (size_t)l * INC * D * 2);
          pg8::EpiBf16Plain E{(bf16_t*)(P.ws + OFF_P), INC};
          pg8::gemm_phase<pg8::EpiBf16Plain, pg8::SchedDense>(lds, D, D, S, E); }
        GRID_SYNC(sb + 1);
#pragma unroll 1
        for (int sp = 0; sp < 3; ++sp) {
        if (sp == 1) {
        if (bid < 64) { if (EN(4)) ph_chain(PK, 0, bid, lds); if (PROF_A >= 0 && l == 0 && bid == 0 && opaque_tid() == 0) ((unsigned long long*)(PK.ws + OFF_CTL + 15360))[50] = __builtin_amdgcn_s_memrealtime(); }
        else if (EN(5)) { const Params P = launder(PK);
            const int vb = bid - 64, nvb = G - 64;
            for (int task = vb; task < 256; task += nvb) { const int b = task >> 7, t2 = task & 127;
                dft_task<128>((const bf16_t*)(P.ws + OFF_D1), (const bf16_t*)(P.ws + OFF_P) + (size_t)(b * T + t2) * INC + 2048, (size_t)128 * INC, smem, 0, b, t2, (bf16_t*)(P.ws + OFF_Y1), (bf16_t*)(P.ws + OFF_MIX)); }
            const int npool = (l == 0) ? 514 : 512;
            if (PROF_A >= 0 && l == 0 && bid == 64 && opaque_tid() == 0) ((unsigned long long*)(PK.ws + OFF_CTL + 15360))[54] = __builtin_amdgcn_s_memrealtime();
            for (int task = vb; task < npool; task += nvb) ph_pool_task(PK, task, smem);
            if (l == 0) for (int task = nvb - 1 - vb; task < 4; task += nvb) { const int b = task >> 1, half = task & 1;
                dft_task<256>((const bf16_t*)(P.ws + OFF_DCTX) + (size_t)half * 65536, (const bf16_t*)(P.ws + OFF_P) + (size_t)(LAT + b * TC) * INC + 2048, INC, smem, 2, b, half, (bf16_t*)(P.ws + OFF_Y1), (bf16_t*)(P.ws + OFF_MIX)); }
            if (PROF_A >= 0 && l == 0 && bid == 64 && opaque_tid() == 0) ((unsigned long long*)(PK.ws + OFF_CTL + 15360))[51] = __builtin_amdgcn_s_memrealtime();
        }
        }
        { int sbid = bid, snb = G, sb1 = 0, stb = 0, snt = 2080; bool run = true;
          if (sp == 1) { run = (bid >= 64); sbid = G - 1 - bid; snb = G - 64; sb1 = 1; snt = SA_EARLY; }
          else if (sp == 2) { sb1 = 1; stb = SA_EARLY; snt = 2080 - SA_EARLY; }
          if (run && EN(3)) ph_sa(PK, l, sb1, smem, sbid, snb, stb, snt); }
        GRID_SYNC(sb + 2 + sp);
        }
#pragma unroll 1
        for (int rp = 0; rp < 2; ++rp) {
        if (rp == 0) {
        if (bid < 64) { if (EN(4)) ph_chain(PK, 1, bid, lds); if (PROF_A >= 0 && l == 0 && bid == 0 && opaque_tid() == 0) ((unsigned long long*)(PK.ws + OFF_CTL + 15360))[52] = __builtin_amdgcn_s_memrealtime(); }
        else if (EN(6)) { const Params P = launder(PK);
            const int vb = bid - 64, nvb = G - 64;
            for (int task = vb; task < 256; task += nvb) { const int b = task >> 7, k1 = task & 127;
                dft_task<256>((const bf16_t*)(P.ws + OFF_E2) + (size_t)k1 * 65536, (const bf16_t*)(P.ws + OFF_Y1) + (size_t)(b * 128 + k1) * 65536, 256, smem, 1, b, k1, (bf16_t*)(P.ws + OFF_Y1), (bf16_t*)(P.ws + OFF_MIX)); }
        }
        }
        if (EN(7) && (rp == 1 || bid >= 64)) ph_readout(PK, l, smem, bid, G, rp);
        GRID_SYNC(sb + 5 + rp);
        }
        if (EN(8)) { const Params P = launder(PK); pg8::SchedDense S; S.init(LAT, D, MIXK, G, bid, P.ws + OFF_MIX, P.ws + OFF_WOT + (size_t)l * D * MIXK * 2);
          pg8::EpiResid E{P.out, (float*)(P.ws + OFF_HCTX), (const float*)(P.ws + OFF_MODS) + (size_t)l * 3 * 6144};
          pg8::gemm_phase<pg8::EpiResid, pg8::SchedDense>(lds, MIXK, MIXK, S, E); }
        if (EN(8) && l == 0) { const Params P = launder(PK);
          pg8::SchedCtxK S{bid, (const char*)(P.ws + OFF_MIX) + (size_t)LAT * MIXK * 2, (const char*)(P.ws + OFF_WOT), nullptr};
          pg8::EpiSlab E{(float*)(P.ws + OFF_SLAB)};
          pg8::gemm_phase<pg8::EpiSlab, pg8::SchedCtxK>(lds, 256, MIXK, S, E); }
        GRID_SYNC(sb + 7);
        if (EN(9)) ph_norm2(PK, l, smem, bid, G);
        GRID_SYNC(sb + 8);
        if (bid < 64) { if (EN(10)) if (bid < 32 || l == 0) ph_topk_task(PK, bid, smem); if (PROF_A >= 0 && l == 0 && bid == 0 && opaque_tid() == 0) ((unsigned long long*)(PK.ws + OFF_CTL + 15360))[55] = __builtin_amdgcn_s_memrealtime(); }
        if (EN(11)) { int t0, t1;
            if (G == 256) { if (bid < 32) { t0 = 5 * bid; t1 = t0 + 5; } else if (bid < 64) { t0 = 160 + 12 * (bid - 32); t1 = t0 + 12; }
                            else if (bid < 96) { t0 = 544 + 14 * (bid - 64); t1 = t0 + 14; } else { t0 = 992 + 13 * (bid - 96); t1 = t0 + 13; } }
            else { const int per = (3072 + G - 1) / G; t0 = bid * per; t1 = min(t0 + per, 3072); }
            ph_convw(PK, l, smem, t0, t1); if (PROF_A >= 0 && l == 0 && bid == 64 && opaque_tid() == 0) ((unsigned long long*)(PK.ws + OFF_CTL + 15360))[56] = __builtin_amdgcn_s_memrealtime(); }
        GRID_SYNC(sb + 9);
        if (EN(12)) { const Params P = launder(PK); pg8::SchedMoe1 S{bid, l == 0, (const char*)(P.ws + OFF_XN), (const char*)(P.ws + OFF_WGU), (size_t)256 * D * 2, (const int*)(P.ws + OFF_IDX)};
          pg8::EpiSwiglu E{(bf16_t*)(P.ws + OFF_HID)};
          pg8::gemm_phase<pg8::EpiSwiglu, pg8::SchedMoe1>(lds, D, D, S, E); }
        GRID_SYNC(sb + 11);
        if (EN(13)) { const Params P = launder(PK); pg8::SchedMoe2 S{bid, false, (const char*)(P.ws + OFF_HID), (const char*)(P.ws + OFF_WD), (size_t)256 * D * 2, nullptr};
          pg8::EpiScaleRow E{(bf16_t*)(P.ws + OFF_XE), (const float*)(P.ws + OFF_GATE)};
          pg8::gemm_phase<pg8::EpiScaleRow, pg8::SchedMoe2>(lds, D, D, S, E); }
        if (EN(13) && l == 0) ph_moe2_ctx(PK, bid, G);
        GRID_SYNC(sb + 12);
    }
    if (EN(1)) ph_norm1(PK, 2, smem, bid, G);
    if (PROF_A >= 0) {
        GRID_SYNC(28);
        const unsigned long long* ts = (const unsigned long long*)(PK.ws + OFF_CTL + 15360);
        const float da = PROF_BINS * log2f(fmaxf((float)(ts[PROF_A] - ts[PROF_A0]) * 0.01f, 1.0f)), db = PROF_BINS * log2f(fmaxf((float)(ts[PROF_B] - ts[PROF_B0]) * 0.01f, 1.0f));
        const float c = sqrtf(floorf(da + 0.5f));
        const int t2_ = opaque_tid();
        for (size_t i = (size_t)bid * NT + t2_; i < (size_t)LAT * D; i += (size_t)G * NT) PK.out[i] = (i & 1) ? -c : c;
        if (bid == 0 && t2_ == 0) PK.out[0] = 100.0f + 10.0f * floorf(db + 0.5f);
    }
}

extern "C" void kernel_launch(void* const* d_in, const int* in_sizes, int n_in, void* d_out, int out_size, void* d_ws, size_t ws_size, hipStream_t stream) {
    static int grid = 0;
    if (grid == 0) {
        if (n_in != 29 || out_size != LAT * D || ws_size < WS_NEED) { fprintf(stderr, "kernel_launch: unexpected shapes (n_in %d, out %d, ws %zu < %zu)\n", n_in, out_size, ws_size, (size_t)WS_NEED); grid = -1; return; }
        int dev = 0, cus = 0;
        if (hipGetDevice(&dev) != hipSuccess || hipDeviceGetAttribute(&cus, hipDeviceAttributeMultiprocessorCount, dev) != hipSuccess) { grid = -1; return; }
        if (hipFuncSetAttribute((const void*)hybrid_fwd, hipFuncAttributeMaxDynamicSharedMemorySize, LDS_BYTES) != hipSuccess) { fprintf(stderr, "kernel_launch: hipFuncSetAttribute failed\n"); grid = -1; return; }
        (void)hipGetLastError();
        grid = cus;
    }
    if (grid < 0) return;
    if (hipMemsetAsync((char*)d_ws + OFF_CTL, 0, 16384, stream) != hipSuccess) return;
    Params p{};
    for (int i = 0; i < 29; ++i) p.in[i] = (const float*)d_in[i];
    p.out = (float*)d_out; p.ws = (unsigned char*)d_ws;
    hipLaunchKernelGGL(hybrid_fwd, dim3(grid), dim3(NT), LDS_BYTES, stream, p);
}
```

```cpp
#include <hip/hip_runtime.h>
#include <cstdio>
#include <cstdint>
#include <cmath>

#define LAS __attribute__((address_space(3)))
typedef unsigned short bf16_t;
typedef short bf16x8 __attribute__((ext_vector_type(8)));
typedef float f32x4 __attribute__((ext_vector_type(4)));
typedef float f32x2 __attribute__((ext_vector_type(2)));
typedef unsigned u32x4 __attribute__((ext_vector_type(4)));
typedef unsigned u32x2 __attribute__((ext_vector_type(2)));

constexpr int NB = 2, T = 16384, TC = 256, D = 1024;
constexpr int LAT = NB * T, MT = LAT + NB * TC;
constexpr int INC = 2304, MIXK = 1280;
constexpr int CAP = 2048, CAPC = 32;
constexpr int XE_ROWS = 65536 + 32 * 256;
constexpr int NT = 512;
constexpr int SA_EARLY = 288;
constexpr int NPREP = 96;

constexpr size_t OFF_CTL   = 0;
constexpr size_t OFF_MODS  = 16384;
constexpr size_t OFF_WINT  = OFF_MODS + 147456;
constexpr size_t OFF_WOT   = OFF_WINT + 9437184;
constexpr size_t OFF_DUPT  = OFF_WOT + 5242880;
constexpr size_t OFF_IUPT  = OFF_DUPT + 262144;
constexpr size_t OFF_GUPT  = OFF_IUPT + 262144;
constexpr size_t OFF_WCS   = OFF_GUPT + 262144;
constexpr size_t OFF_D1    = OFF_WCS + 262144;
constexpr size_t OFF_DCTX  = OFF_D1 + 65536;
constexpr size_t OFF_E2    = OFF_DCTX + 262144;
constexpr size_t OFF_HCTX  = OFF_E2 + 16777216;
constexpr size_t OFF_AFF   = OFF_HCTX + 2097152;
constexpr size_t OFF_AFFC  = OFF_AFF + 2097152;
constexpr size_t OFF_IDX   = OFF_AFFC + 32768;
constexpr size_t OFF_GATE  = OFF_IDX + 294912;
constexpr size_t OFF_INV   = OFF_GATE + 294912;
constexpr size_t OFF_BONUS = OFF_INV + 2129920;
constexpr size_t OFF_XN    = OFF_BONUS + 2129920;
constexpr size_t OFF_BIG   = OFF_XN + 68157440;
constexpr size_t OFF_P     = OFF_BIG;
constexpr size_t OFF_MIX   = OFF_P + 153354240;
constexpr size_t OFF_GH    = OFF_MIX + 85196800;
constexpr size_t OFF_GY    = OFF_GH + 68157440;
constexpr size_t OFF_Y1    = OFF_GY + 136314880;
constexpr size_t OFF_SLAB  = OFF_Y1 + 33554432;
constexpr size_t OFF_GH2   = OFF_SLAB;
constexpr size_t END_MIXV  = OFF_SLAB + 17039360;
constexpr size_t OFF_WGU   = OFF_BIG;
constexpr size_t OFF_WD    = OFF_WGU + 67108864;
constexpr size_t OFF_XE    = OFF_WD + 33554432;
constexpr size_t OFF_HID   = OFF_XE + 150994944;
constexpr size_t END_MOEV  = OFF_HID + 150994944;
constexpr size_t WS_NEED   = END_MIXV > END_MOEV ? END_MIXV : END_MOEV;

constexpr int SLOT = 8192;
constexpr int LDS_LW   = 14 * SLOT;
constexpr int LDS_SEG  = LDS_LW + 64 * 68 * 4;
constexpr int LDS_GL   = LDS_SEG + 16 * 64 * 4;
constexpr int LDS_BON  = LDS_GL + 256;
constexpr int LDS_MISC = 148992;
static_assert(LDS_BON + 256 <= LDS_MISC, "LDS map");
constexpr int LDS_MISC_UNUSED = LDS_BON + 256;
constexpr int LDS_BYTES = LDS_MISC + 256;

#ifndef PROF_SA
#define PROF_SA 0
#endif
#ifndef PROF_A
#define PROF_BINS 4.0f
#define PROF_A -1
#define PROF_B -1
#define PROF_A0 (PROF_A - 1)
#define PROF_B0 (PROF_B - 1)
#define PROF_UNIT 10.0f
#endif
#ifndef DUMP_OFF
#define DUMP_OFF 0
#define DUMP_WORDS 0
#endif
#ifndef STOP_AFTER
#define STOP_AFTER 0
#endif
#ifndef PHMASK
#define PHMASK 0xffffffffu
#endif
#define EN(n) (((PHMASK) >> (n)) & 1u)
struct Params { const float* in[29]; float* out; unsigned char* ws; };


__device__ __forceinline__ int opaque_tid() { int t = threadIdx.x; asm volatile("" : "+v"(t)); return t; }
__device__ __forceinline__ Params launder(const Params& P0) {
    typedef const __attribute__((address_space(4))) Params* kparams_t;
    kparams_t kp = (kparams_t)__builtin_amdgcn_kernarg_segment_ptr();
    asm volatile("" : "+s"(kp));
    (void)P0;
    Params Q;
#pragma unroll
    for (int i = 0; i < 29; ++i) Q.in[i] = (const float*)(const __attribute__((address_space(1))) float*)kp->in[i];
    Q.out = (float*)(__attribute__((address_space(1))) float*)kp->out; Q.ws = (unsigned char*)(__attribute__((address_space(1))) unsigned char*)kp->ws;
    return Q;
}
__device__ __forceinline__ float bf2f(unsigned b) { return __uint_as_float(b << 16); }
template <typename T> __device__ __forceinline__ T ldo(const void* base, unsigned byteoff) { return *(const T*)((const char*)base + byteoff); }
typedef __bf16 bf16v2_t __attribute__((ext_vector_type(2)));
typedef float f32v2_t __attribute__((ext_vector_type(2)));
__device__ __forceinline__ unsigned cvt_pk(float lo, float hi) { const f32v2_t v = {lo, hi}; const bf16v2_t b = __builtin_convertvector(v, bf16v2_t); return __builtin_bit_cast(unsigned, b); }
__device__ __forceinline__ bf16_t f2bf(float f) { return (bf16_t)(cvt_pk(f, 0.f) & 0xffffu); }
template <int M> __device__ __forceinline__ float sx(float x, int lane) {
    if constexpr (M < 32) return __int_as_float(__builtin_amdgcn_ds_swizzle(__float_as_int(x), (M << 10) | 0x1F));
    else return __int_as_float(__builtin_amdgcn_ds_bpermute((lane ^ M) << 2, __float_as_int(x)));
}
__device__ __forceinline__ float wave_sum(float v, int lane) {
    v += sx<1>(v, lane); v += sx<2>(v, lane); v += sx<4>(v, lane); v += sx<8>(v, lane); v += sx<16>(v, lane); v += sx<32>(v, lane);
    return v;
}
__device__ __forceinline__ float sigmoidf_(float x) { return __builtin_amdgcn_rcpf(1.0f + __expf(-x)); }

#define XB_TMO      128
#define XB_XCNT(j)  (256  + 64 * (j))
#define XB_XSUB(j)  (1280 + 64 * (j))
#define XB_XGEN(j)  (2304 + 64 * (j))
#define XB_TOP      3328
#define XB_TOPGEN   3392
#define XCD_BAR_WORDS 3456
#define XB_SPIN_CAP (1u << 22)
__device__ __forceinline__ unsigned xb_ld(unsigned* p)              { return __hip_atomic_load(p, __ATOMIC_RELAXED, __HIP_MEMORY_SCOPE_AGENT); }
__device__ __forceinline__ unsigned xb_add(unsigned* p, unsigned v) { return __hip_atomic_fetch_add(p, v, __ATOMIC_RELAXED, __HIP_MEMORY_SCOPE_AGENT); }
__device__ __forceinline__ unsigned xb_xcc_id() { return (unsigned)__builtin_amdgcn_s_getreg((3 << 11) | 20) & 0xFu; }
#define XB_SPIN(cond, bar) do { unsigned _sp = 0; while (cond) { __builtin_amdgcn_s_sleep(1); \
    if ((++_sp & 255u) == 0u) { if (xb_ld(&(bar)[XB_TMO])) break; if (_sp > XB_SPIN_CAP) { atomicAdd(&(bar)[XB_TMO], 1u); break; } } } } while (0)
struct XcdBarrier { unsigned* bar; unsigned x; volatile LAS unsigned* st; };
__device__ __forceinline__ XcdBarrier xcd_barrier_post(unsigned* bar, volatile LAS unsigned* st) {
    XcdBarrier b; b.bar = bar; b.x = xb_xcc_id(); b.st = st;
    if (threadIdx.x == 0) (void)xb_add(&bar[XB_XCNT(b.x)], 1u);
    return b;
}
__device__ __forceinline__ void xcd_barrier_complete(unsigned* bar, unsigned x, unsigned& nloc, unsigned& nx) {
    const unsigned G = gridDim.x * gridDim.y * gridDim.z;
    unsigned sum, cnt, mine, sp = 0u;
    for (;;) {
        sum = 0u; cnt = 0u; mine = 0u;
#pragma unroll
        for (unsigned j = 0; j < 16; ++j) { const unsigned c = xb_ld(&bar[XB_XCNT(j)]); sum += c; cnt += (c > 0u) ? 1u : 0u; mine = (j == x) ? c : mine; }
        if (sum == G) break;
        __builtin_amdgcn_s_sleep(1);
        if ((++sp & 255u) == 0u) { if (xb_ld(&bar[XB_TMO])) break; if (sp > XB_SPIN_CAP) { atomicAdd(&bar[XB_TMO], 1u); break; } }
    }
    nloc = mine > 0u ? mine : 1u; nx = cnt > 0u ? cnt : 1u;
}
__device__ __forceinline__ void xcd_barrier(const XcdBarrier& b) {
    asm volatile("s_waitcnt vmcnt(0)" ::: "memory");
    __syncthreads();
    if (threadIdx.x == 0) {
        unsigned* bar = b.bar;
        __builtin_amdgcn_s_waitcnt(0);
        unsigned nloc = b.st[0], nx = b.st[1];
        if (nloc == 0u) { xcd_barrier_complete(bar, b.x, nloc, nx); b.st[0] = nloc; b.st[1] = nx; }
        const unsigned old = xb_add(&bar[XB_XSUB(b.x)], 1u);
        const unsigned gen = old / nloc;
        if (old + 1u == (gen + 1u) * nloc) {
            __builtin_amdgcn_fence(__ATOMIC_RELEASE, "agent");
            asm volatile("s_waitcnt vmcnt(0)" ::: "memory");
            const unsigned og = xb_add(&bar[XB_TOP], 1u);
            const unsigned tg = og / nx;
            if (og + 1u == (tg + 1u) * nx) xb_add(&bar[XB_TOPGEN], 1u);
            else XB_SPIN(xb_ld(&bar[XB_TOPGEN]) == tg, bar);
            __builtin_amdgcn_fence(__ATOMIC_ACQUIRE, "agent");
            xb_add(&bar[XB_XGEN(b.x)], 1u);
            asm volatile("s_waitcnt vmcnt(0)" ::: "memory");
        } else {
            XB_SPIN(xb_ld(&bar[XB_XGEN(b.x)]) == gen, bar);
            __builtin_amdgcn_fence(__ATOMIC_ACQUIRE, "agent");
            asm volatile("s_waitcnt vmcnt(0)" ::: "memory");
        }
    }
    __syncthreads();
}

namespace pg8 {
constexpr int BM = 256, BK = 64, HALF = 128, HTB = HALF * BK * 2, NXCD = 8, WGM = 8;
__device__ __forceinline__ int lds_byte(int r, int c) { const int st = (r >> 4) * 2 + (c >> 5), rr = r & 15, cc = c & 31, ob = rr * 64 + cc * 2; return st * 1024 + (ob ^ (((ob >> 9) & 1) << 5)); }
__device__ __forceinline__ void stage_rc(int b, int& R, int& C) { const int st = b / 1024, sb = b % 1024, swz = sb ^ (((sb >> 9) & 1) << 5); R = (st >> 1) * 16 + swz / 64; C = (st & 1) * 32 + (swz % 64) / 2; }
__device__ __forceinline__ int perm32(int rho) { const int n = rho >> 4, i = rho & 15; return 8 * (i >> 2) + 4 * n + (i & 3); }
struct Unit { int pm, pn; const char* A; const char* B; int aux; };

template <class Epi, class Sched>
__device__ __forceinline__ void gemm_phase(LAS unsigned char* lds, const int K, const int LDK  , const Sched& S, const Epi& E) {
    const int tid = opaque_tid(), wid = __builtin_amdgcn_readfirstlane(tid >> 6), lane = tid & 63, wr = wid >> 2, wc = wid & 3, fr = lane & 15, fq = lane >> 4;
    const int nt = K / BK;
    unsigned voffA[2], voffB[2];
#pragma unroll
    for (int i = 0; i < 2; ++i) { int R, C; stage_rc(tid * 16 + i * 8192, R, C); const int Rb = Epi::PERM ? ((R & ~31) + perm32(R & 31)) : R;
        voffA[i] = (unsigned)(R * LDK + C) * 2u; voffB[i] = (unsigned)(Rb * LDK + C) * 2u; }
    const LAS int* lidx = (const LAS int*)(lds + 8 * HTB);
    if constexpr (Sched::GATHER) { Unit u_; const int t_ = opaque_tid();
        int iv_[16];
#pragma unroll
        for (int i_ = 0; i_ < 16; ++i_) { iv_[i_] = 0; if (S.next(i_, u_) && t_ < BM) iv_[i_] = S.idx[(size_t)u_.pm * BM + t_]; }
        __builtin_amdgcn_sched_barrier(0);
#pragma unroll
        for (int i_ = 0; i_ < 16; ++i_) if (t_ < BM) ((LAS int*)(lds + 8 * HTB))[i_ * BM + t_] = iv_[i_];
        __syncthreads(); }
    unsigned vgc[2][2] = {{0u, 0u}, {0u, 0u}}, vgn[2][2] = {{0u, 0u}, {0u, 0u}};
#define PG8_GLOAD(vg, unit) do { if constexpr (Sched::GATHER) { _Pragma("unroll") for (int hh_ = 0; hh_ < 2; ++hh_) _Pragma("unroll") for (int i_ = 0; i_ < 2; ++i_) \
        { int R_, C_; stage_rc(opaque_tid() * 16 + i_ * 8192, R_, C_); vg[hh_][i_] = (unsigned)lidx[(unit) * BM + hh_ * HALF + R_] * (unsigned)(LDK * 2) + (unsigned)C_ * 2u; } } } while (0)
#define PG8_STAGE_A(bufoff, base, hh, nx) do { if constexpr (Sched::GATHER) { const unsigned vt_[2] = {(nx) ? vgn[hh][0] : vgc[hh][0], (nx) ? vgn[hh][1] : vgc[hh][1]}; PG8_STAGE(bufoff, base, vt_); } \
        else { PG8_STAGE(bufoff, (base) + (hh) * hstep, voffA); } } while (0)
    const size_t kstep = (size_t)(BK * 2);
    const size_t hstep = (size_t)HALF * LDK * 2;
    const unsigned ldsw = (unsigned)wid * 1024u;
    const int aoff = lds_byte(wr * 64 + fr, fq * 8), boff = lds_byte(wc * 32 + fr, fq * 8);
#define PG8_SA(b, h) (((b) * 2 + (h)) * HTB)
#define PG8_SB(b, h) ((4 + (b) * 2 + (h)) * HTB)
#define PG8_STAGE(bufoff, gbase, voff) do { _Pragma("unroll") for (int _i = 0; _i < 2; ++_i) \
        __builtin_amdgcn_global_load_lds((const unsigned*)((const char*)(gbase) + (voff)[_i]), (LAS unsigned*)(lds + (bufoff) + ldsw + _i * 8192), 16, 0, 0); } while (0)
#define PG8_LDA(dst, b, h) do { _Pragma("unroll") for (int m = 0; m < 4; ++m) _Pragma("unroll") for (int k = 0; k < 2; ++k) dst[m][k] = *(const LAS bf16x8*)(lds + PG8_SA(b, h) + aoff + m * 2048 + k * 1024); } while (0)
#define PG8_LDB(dst, b, h) do { _Pragma("unroll") for (int n = 0; n < 2; ++n) _Pragma("unroll") for (int k = 0; k < 2; ++k) dst[n][k] = *(const LAS bf16x8*)(lds + PG8_SB(b, h) + boff + n * 2048 + k * 1024); } while (0)
#define PG8_MMA(ai, bj, At, Bt) do { __builtin_amdgcn_s_setprio(1); _Pragma("unroll") for (int m = 0; m < 4; ++m) _Pragma("unroll") for (int n = 0; n < 2; ++n) _Pragma("unroll") for (int k = 0; k < 2; ++k) \
        acc[ai][bj][m][n] = __builtin_amdgcn_mfma_f32_16x16x32_bf16(Bt[n][k], At[m][k], acc[ai][bj][m][n], 0, 0, 0); __builtin_amdgcn_s_setprio(0); } while (0)
#define PG8_WAIT_V(n) asm volatile("s_waitcnt vmcnt(" #n ")" ::: "memory")
#define PG8_WAIT_L(n) asm volatile("s_waitcnt lgkmcnt(" #n ")" ::: "memory")
#define PG8_BAR __builtin_amdgcn_s_barrier()
#define PG8_SCHED __builtin_amdgcn_sched_barrier(0)
    Unit cur, nxt; int ui = 0;
    if (!S.next(0, cur)) return;
    f32x4 acc[2][2][4][2];
#pragma unroll
    for (int a = 0; a < 2; ++a)
#pragma unroll
        for (int b = 0; b < 2; ++b)
#pragma unroll
            for (int m = 0; m < 4; ++m)
#pragma unroll
                for (int n = 0; n < 2; ++n) acc[a][b][m][n] = (f32x4){0.f, 0.f, 0.f, 0.f};
    bf16x8 At[4][2], B0[2][2], B1[2][2];
    const char* cA = cur.A; const char* cB = cur.B;
    PG8_GLOAD(vgc, 0);
    PG8_STAGE(PG8_SB(0, 0), cB, voffB); PG8_STAGE_A(PG8_SA(0, 0), cA, 0, false); PG8_STAGE(PG8_SB(0, 1), cB + hstep, voffB); PG8_STAGE_A(PG8_SA(0, 1), cA, 1, false);
    if (wr == 1) PG8_BAR;
    PG8_WAIT_V(4); PG8_BAR;
    PG8_STAGE(PG8_SB(1, 0), cB + kstep, voffB); PG8_STAGE_A(PG8_SA(1, 0), cA + kstep, 0, false); PG8_STAGE(PG8_SB(1, 1), cB + hstep + kstep, voffB);
    PG8_WAIT_V(6); PG8_BAR;
    for (;;) {
        const bool has_next = S.next(ui + 1, nxt);
        const char* nA = has_next ? nxt.A : cA; const char* nB = has_next ? nxt.B : cB;
        if constexpr (Sched::GATHER) { if (has_next) PG8_GLOAD(vgn, ui + 1); else { vgn[0][0] = vgc[0][0]; vgn[0][1] = vgc[0][1]; vgn[1][0] = vgc[1][0]; vgn[1][1] = vgc[1][1]; } }
        for (int t = 0; t < nt; t += 2) {
            const bool last = (t == nt - 2);
            const char* a1 = cA + (size_t)(t + 1) * kstep;
            const char* a2 = last ? nA : cA + (size_t)(t + 2) * kstep; const char* b2 = last ? nB : cB + (size_t)(t + 2) * kstep;
            const char* a3 = a2 + kstep; const char* b3 = b2 + kstep;
            PG8_LDB(B0, 0, 0); PG8_SCHED; PG8_LDA(At, 0, 0); PG8_STAGE_A(PG8_SA(1, 1), a1, 1, false);
            PG8_WAIT_L(8); PG8_BAR; PG8_WAIT_L(0); PG8_MMA(0, 0, At, B0); PG8_BAR; PG8_SCHED;
            PG8_LDB(B1, 0, 1); PG8_STAGE(PG8_SB(0, 0), b2, voffB);
            PG8_BAR; PG8_WAIT_L(0); PG8_MMA(0, 1, At, B1); PG8_BAR;
            PG8_LDA(At, 0, 1); PG8_STAGE_A(PG8_SA(0, 0), a2, 0, last);
            PG8_BAR; PG8_WAIT_L(0); PG8_MMA(1, 0, At, B0); PG8_BAR; PG8_SCHED;
            PG8_STAGE(PG8_SB(0, 1), b2 + hstep, voffB);
            PG8_WAIT_V(6); PG8_BAR; PG8_MMA(1, 1, At, B1); PG8_BAR;
            PG8_LDB(B0, 1, 0); PG8_SCHED; PG8_LDA(At, 1, 0); PG8_STAGE_A(PG8_SA(0, 1), a2, 1, last);
            PG8_WAIT_L(8); PG8_BAR; PG8_WAIT_L(0); PG8_MMA(0, 0, At, B0); PG8_BAR; PG8_SCHED;
            PG8_LDB(B1, 1, 1); PG8_STAGE(PG8_SB(1, 0), b3, voffB);
            PG8_BAR; PG8_WAIT_L(0); PG8_MMA(0, 1, At, B1); PG8_BAR;
            PG8_LDA(At, 1, 1); PG8_STAGE_A(PG8_SA(1, 0), a3, 0, last);
            PG8_BAR; PG8_WAIT_L(0); PG8_MMA(1, 0, At, B0); PG8_BAR; PG8_SCHED;
            PG8_STAGE(PG8_SB(1, 1), b3 + hstep, voffB);
            PG8_WAIT_V(6); PG8_BAR; PG8_MMA(1, 1, At, B1); PG8_BAR;
        }
        E(acc, cur, wr, wc, fr, fq);
        if (!has_next) break;
#pragma unroll
        for (int a = 0; a < 2; ++a)
#pragma unroll
            for (int b = 0; b < 2; ++b)
#pragma unroll
                for (int m = 0; m < 4; ++m)
#pragma unroll
                    for (int n = 0; n < 2; ++n) acc[a][b][m][n] = (f32x4){0.f, 0.f, 0.f, 0.f};
        cur = nxt; cA = nA; cB = nB; ++ui;
        if constexpr (Sched::GATHER) { vgc[0][0] = vgn[0][0]; vgc[0][1] = vgn[0][1]; vgc[1][0] = vgn[1][0]; vgc[1][1] = vgn[1][1]; }
    }
    PG8_WAIT_V(0);
    if (wr == 0) PG8_BAR;
    PG8_BAR;
#undef PG8_SA
#undef PG8_SB
#undef PG8_STAGE
#undef PG8_STAGE_A
#undef PG8_GLOAD
#undef PG8_LDA
#undef PG8_LDB
#undef PG8_MMA
#undef PG8_WAIT_V
#undef PG8_WAIT_L
#undef PG8_BAR
#undef PG8_SCHED
}

struct SchedDense {
    static constexpr bool GATHER = false;
    int nM, nN, nwg, G, c; const char* A; const char* Bt; size_t tstep; const int* idx;
    __device__ __forceinline__ void init(int M, int N, int K, int G_, int c_, const void* A_, const void* Bt_) { nM = M / BM; nN = N / BM; nwg = nM * nN; G = G_; c = c_; A = (const char*)A_; Bt = (const char*)Bt_; tstep = (size_t)BM * K * 2; idx = nullptr; }
    __device__ __forceinline__ bool next(int i, Unit& u) const {
        const long L = (long)i * G + c; if (L >= nwg) return false;
        int wgid = (int)L; { const int q = nwg / NXCD, r = nwg % NXCD, xcd = wgid % NXCD, off = wgid / NXCD; wgid = (xcd < r ? xcd * (q + 1) : r * (q + 1) + (xcd - r) * q) + off; }
        const int nig = WGM * nN, gid = wgid / nig, fm = gid * WGM, gsz = (nM - fm) < WGM ? (nM - fm) : WGM;
        u.pm = fm + ((wgid % nig) % gsz); u.pn = (wgid % nig) / gsz;
        u.A = A + (size_t)u.pm * tstep; u.B = Bt + (size_t)u.pn * tstep; return true;
    }
};
struct SchedCtxK {
    static constexpr bool GATHER = false;
    int c; const char* A; const char* Bt; const int* idx;
    __device__ __forceinline__ bool next(int i, Unit& u) const {
        if (i != 0 || c >= 40) return false;
        const int ks = c >> 3, pm = (c >> 2) & 1, pn = c & 3;
        u.pm = pm; u.pn = pn; u.aux = ks;
        u.A = A + ((size_t)pm * BM * MIXK + ks * 256) * 2; u.B = Bt + ((size_t)pn * BM * MIXK + ks * 256) * 2; return true;
    }
};
struct EpiSlab {
    static constexpr bool PERM = false;
    float* slab;
    __device__ __forceinline__ void operator()(const f32x4 (&acc)[2][2][4][2], const Unit& u, int wr, int wc, int fr, int fq) const {
        float* base = slab + ((size_t)u.aux * 512 + (size_t)u.pm * BM) * D;
        const int r0 = wr * 64 + fr, col0 = u.pn * BM + wc * 32 + 4 * fq;
#pragma unroll
        for (int ai = 0; ai < 2; ++ai)
#pragma unroll
            for (int m = 0; m < 4; ++m) { float* rowp = base + (size_t)(r0 + ai * HALF + m * 16) * D + col0;
#pragma unroll
                for (int bj = 0; bj < 2; ++bj)
#pragma unroll
                    for (int n = 0; n < 2; ++n) *(f32x4*)(rowp + bj * HALF + n * 16) = acc[ai][bj][m][n]; }
    }
};
struct SchedMoe1 {
    static constexpr bool GATHER = true;
    int c; bool has_ctx; const char* xe; const char* wgu; size_t tstep; const int* idx;
    __device__ __forceinline__ bool next(int i, Unit& u) const {
        int g, pn;
        if (i < 8) { const int q = i * 8 + (c & 7), j = c >> 3; g = q >> 1; u.pm = g * 8 + 4 * (q & 1) + (j & 3); pn = j >> 2; }
        else if (has_ctx && i == 8) { g = c >> 3; pn = c & 7; u.pm = 256 + g; }
        else return false;
        u.pn = pn; u.A = xe; u.B = wgu + ((size_t)(g & 15) * 8 + pn) * tstep; return true;
    }
};
struct SchedMoe2 {
    static constexpr bool GATHER = false;
    int c; bool has_ctx; const char* hid; const char* wd; size_t tstep; const int* idx;
    __device__ __forceinline__ bool next(int i, Unit& u) const {
        int g, pn;
        if (i < 4) { const int j = c >> 3; g = i * 8 + (c & 7); u.pm = g * 8 + (j & 7); pn = j >> 3; }
        else if (has_ctx && i == 4 && c < 128) { g = c >> 2; pn = c & 3; u.pm = 256 + g; }
        else return false;
        u.pn = pn; u.A = hid + (size_t)u.pm * tstep; u.B = wd + ((size_t)(g & 15) * 4 + pn) * tstep; return true;
    }
};

struct EpiBf16Plain {
    static constexpr bool PERM = true;
    bf16_t* O; int ldc;
    __device__ __forceinline__ void operator()(const f32x4 (&acc)[2][2][4][2], const Unit& u, int wr, int wc, int fr, int fq) const {
        const int row0 = u.pm * BM + wr * 64 + fr, col0 = u.pn * BM + wc * 32 + 8 * fq;
#pragma unroll
        for (int ai = 0; ai < 2; ++ai)
#pragma unroll
            for (int m = 0; m < 4; ++m) { bf16_t* rowp = O + (size_t)(row0 + ai * HALF + m * 16) * ldc + col0;
#pragma unroll
                for (int bj = 0; bj < 2; ++bj) { const f32x4 v0 = acc[ai][bj][m][0], v1 = acc[ai][bj][m][1];
                    u32x4 w; w.x = cvt_pk(v0[0], v0[1]); w.y = cvt_pk(v0[2], v0[3]); w.z = cvt_pk(v1[0], v1[1]); w.w = cvt_pk(v1[2], v1[3]);
                    *(u32x4*)(rowp + bj * HALF) = w; } }
    }
};
struct EpiResid {
    static constexpr bool PERM = false;
    float* hlat; float* hctx; const float* mods_l;
    __device__ __forceinline__ void operator()(const f32x4 (&acc)[2][2][4][2], const Unit& u, int wr, int wc, int fr, int fq) const {
        const int rowt = u.pm * BM;
        float* base; int s;
        if (rowt < LAT) { base = hlat + (size_t)rowt * D; s = rowt / T; } else { base = hctx + (size_t)(rowt - LAT) * D; s = 2; }
        const float* g1 = mods_l + s * 6144 + 2048;
        const int r0 = wr * 64 + fr, col0 = u.pn * BM + wc * 32 + 4 * fq;
        f32x4 gv[2][2];
#pragma unroll
        for (int bj = 0; bj < 2; ++bj)
#pragma unroll
            for (int n = 0; n < 2; ++n) gv[bj][n] = *(const f32x4*)(g1 + col0 + bj * HALF + n * 16);
#pragma unroll
        for (int ai = 0; ai < 2; ++ai) {
            f32x4 rv[4][2][2];
#pragma unroll
            for (int m = 0; m < 4; ++m)
#pragma unroll
                for (int bj = 0; bj < 2; ++bj)
#pragma unroll
                    for (int n = 0; n < 2; ++n) rv[m][bj][n] = *(const f32x4*)((const char*)base + (unsigned)(((r0 + ai * HALF + m * 16) * D + col0 + bj * HALF + n * 16) * 4));
            __builtin_amdgcn_sched_barrier(0);
#pragma unroll
            for (int m = 0; m < 4; ++m)
#pragma unroll
                for (int bj = 0; bj < 2; ++bj)
#pragma unroll
                    for (int n = 0; n < 2; ++n) *(f32x4*)((char*)base + (unsigned)(((r0 + ai * HALF + m * 16) * D + col0 + bj * HALF + n * 16) * 4)) = rv[m][bj][n] + gv[bj][n] * acc[ai][bj][m][n];
            __builtin_amdgcn_sched_barrier(0); }
    }
};
struct EpiSwiglu {
    static constexpr bool PERM = true;
    bf16_t* hid;
    __device__ __forceinline__ void operator()(const f32x4 (&acc)[2][2][4][2], const Unit& u, int wr, int wc, int fr, int fq) const {
        const int row0 = u.pm * BM + wr * 64 + fr, f0 = u.pn * HALF + wc * 32 + 8 * fq;
#pragma unroll
        for (int ai = 0; ai < 2; ++ai)
#pragma unroll
            for (int m = 0; m < 4; ++m) { bf16_t* rowp = hid + (size_t)(row0 + ai * HALF + m * 16) * D + f0;
                float o[8];
#pragma unroll
                for (int n = 0; n < 2; ++n)
#pragma unroll
                    for (int j = 0; j < 4; ++j) { const float g = acc[ai][0][m][n][j], up = acc[ai][1][m][n][j]; o[n * 4 + j] = g * __builtin_amdgcn_rcpf(1.0f + __expf(-g)) * up; }
                u32x4 w; w.x = cvt_pk(o[0], o[1]); w.y = cvt_pk(o[2], o[3]); w.z = cvt_pk(o[4], o[5]); w.w = cvt_pk(o[6], o[7]);
                *(u32x4*)rowp = w; }
    }
};
struct EpiScaleRow {
    static constexpr bool PERM = true;
    bf16_t* O; const float* gate;
    __device__ __forceinline__ void operator()(const f32x4 (&acc)[2][2][4][2], const Unit& u, int wr, int wc, int fr, int fq) const {
        const int row0 = u.pm * BM + wr * 64 + fr, col0 = u.pn * BM + wc * 32 + 8 * fq;
        float gsv[2][4];
#pragma unroll
        for (int ai = 0; ai < 2; ++ai)
#pragma unroll
            for (int m = 0; m < 4; ++m) gsv[ai][m] = gate[row0 + ai * HALF + m * 16];
        __builtin_amdgcn_sched_barrier(0);
#pragma unroll
        for (int ai = 0; ai < 2; ++ai)
#pragma unroll
            for (int m = 0; m < 4; ++m) { const int row = row0 + ai * HALF + m * 16; const float gs = gsv[ai][m]; bf16_t* rowp = O + (size_t)row * D + col0;
#pragma unroll
                for (int bj = 0; bj < 2; ++bj) { const f32x4 v0 = acc[ai][bj][m][0] * gs, v1 = acc[ai][bj][m][1] * gs;
                    u32x4 w; w.x = cvt_pk(v0[0], v0[1]); w.y = cvt_pk(v0[2], v0[3]); w.z = cvt_pk(v1[0], v1[1]); w.w = cvt_pk(v1[2], v1[3]);
                    *(u32x4*)(rowp + bj * HALF) = w; } }
    }
};
}

template <int K>
__device__ __forceinline__ f32x4 mm16(const unsigned char* X, int ldx, int x0, const unsigned char* Y, int ldy, int y0, f32x4 acc, int lane) {
    const int r = lane & 15, g = lane >> 4;
#pragma unroll
    for (int k0 = 0; k0 < K; k0 += 32) {
        const bf16x8 xf = *(const bf16x8*)(X + ((size_t)(x0 + r) * ldx + k0 + 8 * g) * 2);
        const bf16x8 yf = *(const bf16x8*)(Y + ((size_t)(y0 + r) * ldy + k0 + 8 * g) * 2);
        acc = __builtin_amdgcn_mfma_f32_16x16x32_bf16(yf, xf, acc, 0, 0, 0);
    }
    return acc;
}
#define SL(i) (smem + (i) * SLOT)
__device__ __forceinline__ int moff(int row, int col) { return row * 128 + ((((col >> 3) ^ ((row >> 1) & 7)) << 4) | ((col & 7) << 1)); }
__device__ __forceinline__ void st_row4(unsigned char* M, int x, int y, f32x4 v) { u32x2 w; w.x = cvt_pk(v[0], v[1]); w.y = cvt_pk(v[2], v[3]); *(u32x2*)(M + moff(x, y)) = w; }
__device__ __forceinline__ void st_col4(unsigned char* M, int x, int y, f32x4 v) {
    const int m0 = moff(y, x), m2 = moff(y + 2, x); const unsigned p01 = cvt_pk(v[0], v[1]), p23 = cvt_pk(v[2], v[3]);
    *(bf16_t*)(M + m0) = (bf16_t)(p01 & 0xffffu); *(bf16_t*)(M + m0 + 128) = (bf16_t)(p01 >> 16);
    *(bf16_t*)(M + m2) = (bf16_t)(p23 & 0xffffu); *(bf16_t*)(M + m2 + 128) = (bf16_t)(p23 >> 16);
}
__device__ __forceinline__ f32x4 ld_row4(const unsigned char* M, int x, int y) { const u32x2 w = *(const u32x2*)(M + moff(x, y));
    return (f32x4){bf2f(w.x & 0xffffu), bf2f(w.x >> 16), bf2f(w.y & 0xffffu), bf2f(w.y >> 16)}; }
__device__ __forceinline__ void unpack8(const bf16x8 v, float* o) {
#pragma unroll
    for (int j = 0; j < 8; ++j) o[j] = bf2f((unsigned short)v[j]);
}
__device__ __forceinline__ bf16x8 pack8(const float* o) { u32x4 w; w.x = cvt_pk(o[0], o[1]); w.y = cvt_pk(o[2], o[3]); w.z = cvt_pk(o[4], o[5]); w.w = cvt_pk(o[6], o[7]); return __builtin_bit_cast(bf16x8, w); }

__device__ __forceinline__ void conv8(const bf16_t* p, const float* sw  , int row, int lo, int hi, int col, float* u) {
    bf16x8 x[3]; f32x4 w0[3], w1[3];
#pragma unroll
    for (int dt = 0; dt < 3; ++dt) { const int rr = row + dt - 1, rc = min(max(rr, lo), hi - 1);
        x[dt] = *(const bf16x8*)(p + (size_t)rc * INC + col);
        const float m = (rr >= lo && rr < hi) ? 1.0f : 0.0f;
        w0[dt] = *(const f32x4*)(sw + dt * 1792 + col) * m; w1[dt] = *(const f32x4*)(sw + dt * 1792 + col + 4) * m; }
#pragma unroll
    for (int j = 0; j < 8; ++j) u[j] = 0.f;
#pragma unroll
    for (int dt = 0; dt < 3; ++dt) { float xf[8]; unpack8(x[dt], xf);
#pragma unroll
        for (int j = 0; j < 4; ++j) { u[j] += xf[j] * w0[dt][j]; u[4 + j] += xf[4 + j] * w1[dt][j]; } }
}
__device__ __forceinline__ f32x4 conv4(const bf16_t* p, const float* sw, int row, int lo, int hi, int col) {
    u32x2 x[3]; f32x4 w[3];
#pragma unroll
    for (int dt = 0; dt < 3; ++dt) { const int rr = row + dt - 1, rc = min(max(rr, lo), hi - 1);
        x[dt] = *(const u32x2*)(p + (size_t)rc * INC + col);
        w[dt] = *(const f32x4*)(sw + dt * 1792 + col) * ((rr >= lo && rr < hi) ? 1.0f : 0.0f); }
    f32x4 u = {0.f, 0.f, 0.f, 0.f};
#pragma unroll
    for (int dt = 0; dt < 3; ++dt) { u[0] += bf2f(x[dt].x & 0xffffu) * w[dt][0]; u[1] += bf2f(x[dt].x >> 16) * w[dt][1]; u[2] += bf2f(x[dt].y & 0xffffu) * w[dt][2]; u[3] += bf2f(x[dt].y >> 16) * w[dt][3]; }
    return u;
}

__device__ __forceinline__ f32x4 conv4l(const bf16_t* p, const float* wl, int row, int lo, int hi, int col) {
    u32x2 x[3]; f32x4 w[3];
#pragma unroll
    for (int dt = 0; dt < 3; ++dt) { const int rr = row + dt - 1, rc = min(max(rr, lo), hi - 1);
        x[dt] = *(const u32x2*)(p + (size_t)rc * INC + col);
        w[dt] = *(const f32x4*)(wl + dt * 64) * ((rr >= lo && rr < hi) ? 1.0f : 0.0f); }
    f32x4 u = {0.f, 0.f, 0.f, 0.f};
#pragma unroll
    for (int dt = 0; dt < 3; ++dt) { u[0] += bf2f(x[dt].x & 0xffffu) * w[dt][0]; u[1] += bf2f(x[dt].x >> 16) * w[dt][1]; u[2] += bf2f(x[dt].y & 0xffffu) * w[dt][2]; u[3] += bf2f(x[dt].y >> 16) * w[dt][3]; }
    return u;
}

__device__ __forceinline__ void ph_mods(const Params& P0, unsigned char* smem, int bid, int nblk) {
    const Params P = launder(P0);
    const int tid = opaque_tid();
    float* sil = (float*)smem;
    float* red = (float*)(smem + 12288);
    for (int i = tid; i < 3072; i += NT) { const float x = (i < 2048) ? P.in[1][i] : P.in[3][i - 2048]; sil[i] = x / (1.0f + __expf(-x)); }
    __syncthreads();
    float* mods = (float*)(P.ws + OFF_MODS);
    const int c = tid & 15, ks = tid >> 4;
    for (int it0 = bid; it0 < 768; it0 += 3 * nblk) {
        float a[3][3];
        const float* w[3];
#pragma unroll
        for (int u = 0; u < 3; ++u) { const int item = min(it0 + u * nblk, 767); a[u][0] = a[u][1] = a[u][2] = 0.f;
            w[u] = P.in[4] + (size_t)(item / 384) * D * 6144 + (item % 384) * 16 + c + (size_t)(ks * 32) * 6144; }
#pragma unroll 8
        for (int k = 0; k < 32; ++k) { const float s0 = sil[ks * 32 + k], s1 = sil[1024 + ks * 32 + k], s2 = sil[2048 + ks * 32 + k];
#pragma unroll
            for (int u = 0; u < 3; ++u) { const float wv = w[u][(size_t)k * 6144]; a[u][0] += s0 * wv; a[u][1] += s1 * wv; a[u][2] += s2 * wv; } }
#pragma unroll
        for (int u = 0; u < 3; ++u) { red[((u * 32 + ks) * 16 + c) * 3 + 0] = a[u][0]; red[((u * 32 + ks) * 16 + c) * 3 + 1] = a[u][1]; red[((u * 32 + ks) * 16 + c) * 3 + 2] = a[u][2]; }
        __syncthreads();
        if (tid < 144) { const int u = tid / 48, s = (tid % 48) >> 4, cc = tid & 15, item = it0 + u * nblk;
            if (item < 768) { float sum = 0.f;
                for (int q = 0; q < 32; ++q) sum += red[((u * 32 + q) * 16 + cc) * 3 + s];
                const int l = item / 384, colo = (item % 384) * 16 + cc;
                mods[(size_t)(l * 3 + s) * 6144 + colo] = sum + P.in[5][l * 6144 + colo]; } }
        __syncthreads();
    }
}
__device__ __forceinline__ void transpose_tile(const float* src, int N, bf16_t* dst, int dld, int kind, int tk, int tn, unsigned char* smem) {
    const int tid = opaque_tid();
    float* tile = (float*)smem;
#pragma unroll
    for (int i = 0; i < 2; ++i) { const int e = tid + i * NT, kk = e >> 4, n4 = (e & 15) * 4;
        const f32x4 v = *(const f32x4*)(src + (size_t)(tk * 64 + kk) * N + tn * 64 + n4);
        tile[kk * 65 + n4] = v[0]; tile[kk * 65 + n4 + 1] = v[1]; tile[kk * 65 + n4 + 2] = v[2]; tile[kk * 65 + n4 + 3] = v[3]; }
    __syncthreads();
    { const int n = tid >> 3, k8 = (tid & 7) * 8; float o[8];
#pragma unroll
      for (int j = 0; j < 8; ++j) o[j] = tile[(k8 + j) * 65 + n];
      const int ng = tn * 64 + n; int row = ng; if (kind == 1) row = (ng >> 7) * 256 + (ng & 127); else if (kind == 2) row = (ng >> 7) * 256 + 128 + (ng & 127);
      *(bf16x8*)(dst + (size_t)row * dld + tk * 64 + k8) = pack8(o); }
    __syncthreads();
}
__device__ __forceinline__ void ph_prep_weights(const Params& P0, unsigned char* smem, int bid, int nblk) {
    const Params P = launder(P0);
    for (int t = bid; t < 2 * 576; t += nblk) { const int l = t / 576, r = t % 576, tk = r / 36, tn = r % 36;
        transpose_tile(P.in[8] + (size_t)l * D * INC, INC, (bf16_t*)(P.ws + OFF_WINT) + (size_t)l * INC * D, D, 0, tk, tn, smem); }
    for (int t = bid; t < 2 * 128; t += nblk) { const int l = t / 128, r = t % 128, tk = r / 16, tn = r % 16;
        transpose_tile(P.in[23] + (size_t)l * D * D, D, (bf16_t*)(P.ws + OFF_WOT) + (size_t)l * D * MIXK, MIXK, 0, tk, tn, smem); }
    for (int t = bid; t < 64; t += nblk) { const int which = t / 32, r = t % 32, m = r / 8, tn = r % 8;
        transpose_tile((which ? P.in[13] : P.in[11]) + (size_t)m * 64 * 512, 512, (bf16_t*)(P.ws + (which ? OFF_IUPT : OFF_DUPT)) + (size_t)m * 512 * 64, 64, 0, 0, tn, smem); }
    for (int t = bid; t < 32; t += nblk) { const int l = t / 16, r = t % 16, tk = r / 8, tn = r % 8;
        transpose_tile(P.in[14] + (size_t)l * 128 * 512, 512, (bf16_t*)(P.ws + OFF_GUPT) + (size_t)l * 512 * 128, 128, 0, tk, tn, smem); }
}
__device__ __forceinline__ void ph_tables(const Params& P0, int bid, int nblk) {
    const Params P = launder(P0);
    const int gt = bid * NT + opaque_tid(), ngt = nblk * NT;
    bf16_t* D1 = (bf16_t*)(P.ws + OFF_D1); bf16_t* DC = (bf16_t*)(P.ws + OFF_DCTX); bf16_t* E2 = (bf16_t*)(P.ws + OFF_E2);
    for (int i = gt; i < 256 * 128; i += ngt) { const int m = i >> 7, t1 = i & 127, k1 = m & 127, ph = (k1 * t1) & 127; float s, c; sincospif((float)ph * (1.0f / 64.0f), &s, &c);
        D1[i] = f2bf((m < 128 ? c : -s) * (1.0f / 32.0f)); }
    for (int i = gt; i < 512 * 256; i += ngt) { const int m = i >> 8, t = i & 255, k = m & 255, ph = (k * t) & 255; float s, c; sincospif((float)ph * (1.0f / 128.0f), &s, &c);
        DC[i] = f2bf((m < 256 ? c : -s) * (1.0f / 128.0f)); }
    for (int i = gt; i < 128 * 256 * 256; i += ngt) { const int k1 = i >> 16, m = (i >> 8) & 255, kk = i & 255, k2 = m & 127, t2 = kk & 127, ph = (t2 * (k1 + 128 * k2)) & 16383;
        float s, c; sincospif((float)ph * (1.0f / 8192.0f), &s, &c);
        const float v = (m < 128) ? (kk < 128 ? c : s) : (kk < 128 ? -s : c);
        E2[i] = f2bf(v * (1.0f / 32.0f)); }
}
__device__ __forceinline__ void ph_fold(const Params& P0, unsigned char* smem, int bid, int nblk) {
    const Params P = launder(P0);
    const int tid = opaque_tid();
    float* coef = (float*)smem;
    float* fwl = (float*)(smem + 16384);
    float* trg = (float*)(smem + 32768);
    for (int item = bid; item < 2 * 12 * 4; item += nblk) {
        const int nq = item & 3, grp = (item >> 2) % 12, l = (item >> 2) / 12;
        const float* wo = P.in[23] + (size_t)l * D * D;
        int rowbase, kbase;
        if (grp < 4) { rowbase = 512 + grp * 64; kbase = 512 + grp * 64;
            for (int e = tid; e < 4096; e += NT) { const int cc = e >> 6, d = e & 63; coef[e] = P.in[20][((size_t)(l * 4 + grp) * 64 + cc) * 64 + d] * P.in[21][l * 256 + grp * 64 + d]; }
        } else { const int hh = (grp - 4) >> 1, reim = (grp - 4) & 1; rowbase = 768 + hh * 64; kbase = 768 + hh * 128 + reim * 64;
            for (int e = tid; e < 4096; e += NT) fwl[e] = P.in[22][(size_t)(l * 4 + hh) * 4096 + e];
            if (tid < 64) { float sn, cs; sincospif((float)tid * (1.0f / 32.0f), &sn, &cs); trg[tid] = reim ? sn : cs; }
            __syncthreads();
            for (int e = tid; e < 4096; e += NT) { const int c = e >> 6, d = e & 63; float acc = 0.f;
                for (int m = 0; m < 64; ++m) acc += trg[(c * m) & 63] * fwl[m * 64 + d];
                coef[e] = acc; } }
        __syncthreads();
        { const int n = nq * 256 + (tid & 255), kh = tid >> 8; float w[64];
#pragma unroll
          for (int d = 0; d < 64; ++d) w[d] = wo[(size_t)(rowbase + d) * D + n];
          bf16_t* dst = (bf16_t*)(P.ws + OFF_WOT) + ((size_t)l * D + n) * MIXK + kbase + kh * 32;
#pragma unroll 1
          for (int kk = 0; kk < 32; ++kk) { const float* cf = coef + (kh * 32 + kk) * 64; float acc = 0.f;
#pragma unroll
              for (int d = 0; d < 64; d += 4) { const f32x4 c4 = *(const f32x4*)(cf + d); acc += (c4[0] * w[d] + c4[1] * w[d + 1]) + (c4[2] * w[d + 2] + c4[3] * w[d + 3]); }
              dst[kk] = f2bf(acc); } }
        __syncthreads();
    }
}
__device__ __forceinline__ void ph_norm1(const Params& P0, int mode, unsigned char* smem, int bid, int nblk) {
    const Params P = launder(P0);
    const int lane = opaque_tid() & 63, gw = bid * 8 + (opaque_tid() >> 6), ngw = nblk * 8;
    const float* mods = (const float*)(P.ws + OFF_MODS);
    float* hctx = (float*)(P.ws + OFF_HCTX);
    const int* inv = (const int*)(P.ws + OFF_INV);
    const bf16_t* ye = (const bf16_t*)(P.ws + OFF_XE);
    bf16_t* xn = (bf16_t*)(P.ws + OFF_XN);
    const int nrows = (mode == 2) ? LAT : MT;
    const int lcur = (mode == 2) ? 1 : mode, lprev = lcur - (mode == 2 ? 0 : 1);
    const float* gn = (mode == 2) ? P.in[28] : P.in[6] + lcur * D;
    float* GA = (float*)smem; float* SB = GA + 3072; float* G2 = SB + 3072;
    { const int t_ = opaque_tid();
      for (int i = t_; i < 3072; i += NT) { const int s_ = i >> 10, c_ = i & 1023;
          if (mode == 2) { GA[i] = gn[c_]; SB[i] = 0.f; }
          else { const float* sh_ = mods + (size_t)(lcur * 3 + s_) * 6144; GA[i] = gn[c_] * (sh_[1024 + c_] + 1.0f); SB[i] = sh_[c_]; }
          G2[i] = (mode != 0) ? mods[(size_t)(lprev * 3 + s_) * 6144 + 5120 + c_] : 0.f; }
      __syncthreads(); }
#define N1_SRC(r_) ((mode == 0) ? (((r_) < LAT) ? P.in[0] + (size_t)(r_) * D : P.in[2] + (size_t)((r_) - LAT) * D) : (((r_) < LAT) ? (const float*)P.out + (size_t)(r_) * D : (const float*)hctx + (size_t)((r_) - LAT) * D))
    f32x4 vn[4]; int ivn = -1;
    if (gw < nrows) {
#pragma unroll
        for (int i = 0; i < 4; ++i) vn[i] = *(const f32x4*)(N1_SRC(gw) + 4 * lane + 256 * i);
        if (mode != 0) ivn = inv[(size_t)gw * 16 + (lane & 15)]; }
    for (int r = gw; r < nrows; r += ngw) {
        const int s = (r < LAT) ? r / T : 2;
        float* hrow = (r < LAT) ? P.out + (size_t)r * D : hctx + (size_t)(r - LAT) * D;
        f32x4 v[4];
#pragma unroll
        for (int i = 0; i < 4; ++i) v[i] = vn[i];
        const int iv = ivn;
        { const int rn = r + ngw;
          if (rn < nrows) {
#pragma unroll
              for (int i = 0; i < 4; ++i) vn[i] = *(const f32x4*)(N1_SRC(rn) + 4 * lane + 256 * i);
              if (mode != 0) ivn = inv[(size_t)rn * 16 + (lane & 15)]; } }
        if (mode != 0) {
            f32x4 a[4] = {{0.f, 0.f, 0.f, 0.f}, {0.f, 0.f, 0.f, 0.f}, {0.f, 0.f, 0.f, 0.f}, {0.f, 0.f, 0.f, 0.f}};
            unsigned em = (unsigned)(__ballot(iv >= 0) & 0xFFFFull);
            while (em) {
                size_t yr[4]; float wq[4];
#pragma unroll
                for (int q = 0; q < 4; ++q) {
                    if (em) { const int e = __builtin_ctz(em); em &= em - 1u; const int slot = __builtin_amdgcn_readlane(iv, e);
                        yr[q] = (r < LAT) ? (size_t)((r / T) * 16 + e) * 2048 + slot : (size_t)65536 + (size_t)(((r - LAT) / TC) * 16 + e) * 256 + slot; wq[q] = 1.0f; }
                    else { yr[q] = 0; wq[q] = 0.0f; } }
                u32x2 w[4][4];
#pragma unroll
                for (int q = 0; q < 4; ++q)
#pragma unroll
                    for (int i = 0; i < 4; ++i) w[q][i] = *(const u32x2*)(ye + yr[q] * D + 4 * lane + 256 * i);
#pragma unroll
                for (int q = 0; q < 4; ++q)
#pragma unroll
                    for (int i = 0; i < 4; ++i) { a[i][0] += wq[q] * bf2f(w[q][i].x & 0xffffu); a[i][1] += wq[q] * bf2f(w[q][i].x >> 16); a[i][2] += wq[q] * bf2f(w[q][i].y & 0xffffu); a[i][3] += wq[q] * bf2f(w[q][i].y >> 16); }
            }
#pragma unroll
            for (int i = 0; i < 4; ++i) v[i] = v[i] + *(const f32x4*)(G2 + s * 1024 + 4 * lane + 256 * i) * a[i];
        }
        if (mode != 2) {
#pragma unroll
            for (int i = 0; i < 4; ++i) *(f32x4*)(hrow + 4 * lane + 256 * i) = v[i];
        }
        float ss = 0.f;
#pragma unroll
        for (int i = 0; i < 4; ++i) ss += (v[i][0] * v[i][0] + v[i][1] * v[i][1]) + (v[i][2] * v[i][2] + v[i][3] * v[i][3]);
        const float rs = rsqrtf(wave_sum(ss, lane) * (1.0f / D) + 1e-6f);
        if (mode == 2) {
#pragma unroll
            for (int i = 0; i < 4; ++i) *(f32x4*)(hrow + 4 * lane + 256 * i) = v[i] * rs * *(const f32x4*)(GA + 4 * lane + 256 * i);
        } else {
#pragma unroll
            for (int i = 0; i < 4; ++i) { const int c = 4 * lane + 256 * i;
                const f32x4 y = v[i] * rs * *(const f32x4*)(GA + s * 1024 + c) + *(const f32x4*)(SB + s * 1024 + c);
                u32x2 w; w.x = cvt_pk(y[0], y[1]); w.y = cvt_pk(y[2], y[3]); *(u32x2*)(xn + (size_t)r * D + c) = w; }
        }
    }
#undef N1_SRC
}

__device__ __forceinline__ void ph_sa(const Params& P0, int l, int b, unsigned char* smem, int bid, int nblk, int tbeg, int ntask) {
    const Params P = launder(P0);
    const int tid = opaque_tid(), lane = tid & 63, wid = __builtin_amdgcn_readfirstlane(tid >> 6), r = lane & 15, g = lane >> 4;
    const bf16_t* p = (const bf16_t*)(P.ws + OFF_P);
    const float* sw = P.in[9] + (size_t)l * 3 * 1792;
    float* LW = (float*)(smem + LDS_LW); float* SEG = (float*)(smem + LDS_SEG); float* GL = (float*)(smem + LDS_GL); float* BON = (float*)(smem + LDS_BON);
    float* bonus = (float*)(P.ws + OFF_BONUS);
    const int tx = wid & 3, ty0 = (wid >> 2) * 2;
    LAS unsigned char* ldsa = (LAS unsigned char*)smem;
#define SA_DMA_LORA(h_, d_) do { if (wid >= 6) { const bf16_t* w_ = (const bf16_t*)(P.ws + (wid == 6 ? OFF_DUPT : OFF_IUPT)) + (size_t)((l * 2 + (d_)) * 512 + (h_) * 64) * 64; \
        _Pragma("unroll") for (int i_ = 0; i_ < 8; ++i_) { const int row_ = 8 * i_ + (lane >> 3), cl_ = (lane & 7) ^ ((row_ >> 1) & 7); \
            __builtin_amdgcn_global_load_lds((const unsigned*)(w_ + row_ * 64 + cl_ * 8), (LAS unsigned*)(ldsa + (wid == 6 ? 5 : 6) * SLOT + i_ * 1024), 16, 0, 0); } } } while (0)
    int nrnd = 0; while ((nrnd + 1) * nblk <= ntask) ++nrnd;
    const int NFULL = nrnd * nblk, NHALF = 2 * (ntask - NFULL);
#define SA_UNIT(q_, tq_, d0_, d1_) do { if ((q_) < NFULL) { tq_ = (q_); d0_ = 0; d1_ = 2; } else if ((q_) - NFULL < NHALF) { tq_ = NFULL + (((q_) - NFULL) >> 1); d0_ = ((q_) - NFULL) & 1; d1_ = d0_ + 1; } else { tq_ = -1; d0_ = 0; d1_ = 0; } } while (0)
    __syncthreads();
    { int tq, d0, d1; SA_UNIT(bid, tq, d0, d1); if (tq >= 0) SA_DMA_LORA((tbeg + tq) / 260, d0); }
    for (int q = bid; ; q += nblk) {
        int tq, dbeg, dend; SA_UNIT(q, tq, dbeg, dend);
        if (tq < 0) break;
        const int h = (tbeg + tq) / 260, j = (tbeg + tq) % 260;
        int tok0, lo, hi;
        if (j < 4) { lo = LAT + b * TC; hi = lo + TC; tok0 = lo + 64 * j; } else { lo = b * T; hi = lo + T; tok0 = lo + 64 * (j - 4); }
        bf16x8 F[8];
        if (wid < 6) {
            const int gsel = (wid == 5) ? 1 : wid, tb = lane >> 3, c8 = (lane & 7) * 8;
            const int col = ((gsel < 3) ? gsel * 512 + h * 64 : (gsel == 3 ? 1536 : 1600)) + c8;
            bf16x8 xr[10]; f32x4 wa[3], wb[3];
#pragma unroll
            for (int k = 0; k < 10; ++k) { const int rc = min(max(tok0 + 8 * tb - 1 + k, lo), hi - 1); xr[k] = *(const bf16x8*)(p + (size_t)rc * INC + col); }
#pragma unroll
            for (int dt = 0; dt < 3; ++dt) { wa[dt] = *(const f32x4*)(sw + dt * 1792 + col); wb[dt] = *(const f32x4*)(sw + dt * 1792 + col + 4); }
            f32x4 kk0 = {1.f, 1.f, 1.f, 1.f}, kk1 = kk0;
            if (wid == 5) { kk0 = *(const f32x4*)(P.in[15] + l * 512 + h * 64 + c8); kk1 = *(const f32x4*)(P.in[15] + l * 512 + h * 64 + c8 + 4); }
            const float mfirst = (tok0 + 8 * tb - 1 >= lo) ? 1.0f : 0.0f, mlast = (tok0 + 8 * tb + 8 < hi) ? 1.0f : 0.0f;
#pragma unroll
            for (int tt = 0; tt < 8; ++tt) { float u[8];
#pragma unroll
                for (int jj = 0; jj < 8; ++jj) u[jj] = 0.f;
#pragma unroll
                for (int dt = 0; dt < 3; ++dt) { float xf[8]; unpack8(xr[tt + dt], xf);
                    const float m = (tt == 0 && dt == 0) ? mfirst : ((tt == 7 && dt == 2) ? mlast : 1.0f);
#pragma unroll
                    for (int jj = 0; jj < 4; ++jj) { u[jj] += xf[jj] * wa[dt][jj] * m; u[4 + jj] += xf[4 + jj] * wb[dt][jj] * m; } }
                if (wid == 3) {
#pragma unroll
                    for (int jj = 0; jj < 8; ++jj) u[jj] = 1.0f - 2.0f * __builtin_amdgcn_rcpf(__expf(2.0f * u[jj]) + 1.0f); }
                if (wid == 5) { float ss = 0.f;
#pragma unroll
                    for (int jj = 0; jj < 8; ++jj) { u[jj] *= (jj < 4 ? kk0[jj] : kk1[jj - 4]); ss += u[jj] * u[jj]; }
                    ss += sx<1>(ss, lane); ss += sx<2>(ss, lane); ss += sx<4>(ss, lane);
                    const float inv = rsqrtf(ss + 1e-12f);
#pragma unroll
                    for (int jj = 0; jj < 8; ++jj) u[jj] *= inv; }
                F[tt] = pack8(u); }
        }
#pragma unroll 1
      for (int d = dbeg; d < dend; ++d) {
        const int n = (d == 0) ? j : ((j < 4) ? 3 - j : 263 - j);
        unsigned char* gout = P.ws + ((b == 1 && h < 2) ? OFF_GH2 : OFF_GH) + (size_t)((h * 2 + d) * 260 + n) * 16384;
        unsigned char* gyout = P.ws + OFF_GY + (size_t)(((b * 8 + h) * 2 + d) * 260 + n) * 16384;
        f32x4 kav[2], rkv[2], w0v[2], a0v[2];
#pragma unroll
        for (int tyi = 0; tyi < 2; ++tyi) { w0v[tyi] = *(const f32x4*)(P.in[10] + (l * 2 + d) * 512 + h * 64 + 16 * (ty0 + tyi) + 4 * g); a0v[tyi] = *(const f32x4*)(P.in[12] + (l * 2 + d) * 512 + h * 64 + 16 * (ty0 + tyi) + 4 * g);
            kav[tyi] = *(const f32x4*)(P.in[16] + l * 512 + h * 64 + 16 * (ty0 + tyi) + 4 * g); rkv[tyi] = *(const f32x4*)(P.in[17] + l * 512 + h * 64 + 16 * (ty0 + tyi) + 4 * g); }
        { if (wid < 6) { const int sl = (wid == 0) ? 8 : (wid == 1) ? 9 : (wid == 2) ? 11 : (wid == 3) ? 12 : (wid == 4) ? 13 : 10, tb = lane >> 3, c8 = (lane & 7) * 8;
#pragma unroll
              for (int tt = 0; tt < 8; ++tt) *(bf16x8*)(SL(sl) + moff(8 * tb + tt, c8)) = F[tt]; }
          if (tid < 64) BON[tid] = 0.f; }
        if (wid >= 6) asm volatile("s_waitcnt vmcnt(0)" ::: "memory");
        __syncthreads();
        { const int t = 16 * tx + r; float bon = 0.f;
#pragma unroll
          for (int tyi = 0; tyi < 2; ++tyi) { const int cy = ty0 + tyi;
            f32x4 aw = {0.f, 0.f, 0.f, 0.f}, aa = {0.f, 0.f, 0.f, 0.f};
#pragma unroll
            for (int ks = 0; ks < 2; ++ks) {
                const bf16x8 xw = *(const bf16x8*)(SL(12) + moff(t, 32 * ks + 8 * g)), xa = *(const bf16x8*)(SL(13) + moff(t, 32 * ks + 8 * g));
                const bf16x8 ywf = *(const bf16x8*)(SL(5) + moff(16 * cy + r, 32 * ks + 8 * g)), yaf = *(const bf16x8*)(SL(6) + moff(16 * cy + r, 32 * ks + 8 * g));
                aw = __builtin_amdgcn_mfma_f32_16x16x32_bf16(ywf, xw, aw, 0, 0, 0); aa = __builtin_amdgcn_mfma_f32_16x16x32_bf16(yaf, xa, aa, 0, 0, 0); }
            const int c = 16 * cy + 4 * g, hc = h * 64 + c;
            const f32x4 w0 = w0v[tyi], a0 = a0v[tyi];
            const f32x4 ka = kav[tyi], rk = rkv[tyi];
            const f32x4 kv = ld_row4(SL(9), t, c), kkv = ld_row4(SL(10), t, c), rv = ld_row4(SL(8), t, c);
            f32x4 lw, kd, bb;
#pragma unroll
            for (int j = 0; j < 4; ++j) { const float x = -(w0[j] + aw[j]);
                lw[j] = -0.60653065971f * __builtin_amdgcn_rcpf(1.0f + __expf(x));
                const float al = sigmoidf_(a0[j] + aa[j]);
                kd[j] = kv[j] * (1.0f + (al - 1.0f) * ka[j]); bb[j] = kkv[j] * al; bon += rv[j] * kd[j] * rk[j]; }
            *(f32x4*)(LW + t * 68 + c) = lw;
            st_row4(SL(9), t, c, kd); st_row4(SL(2), t, c, bb); }
          bon += sx<16>(bon, lane); bon += sx<32>(bon, lane);
          if (g == 0) atomicAdd(&BON[t], bon); }
        __syncthreads();
        if (tid < 64) bonus[((size_t)d * MT + tok0 + tid) * 8 + h] = BON[tid];
        { const int cp = tid & 31, c0 = 2 * cp, sq = tid >> 5;
          float lw0[4], lw1[4], cu0[4], cu1[4]; float run0 = 0.f, run1 = 0.f;
#pragma unroll
          for (int qq = 0; qq < 4; ++qq) { const int i = 4 * sq + qq, tl = d ? 63 - i : i; const f32x2 l2 = *(const f32x2*)(LW + tl * 68 + c0);
              lw0[qq] = l2[0]; lw1[qq] = l2[1]; run0 += l2[0]; run1 += l2[1]; cu0[qq] = run0; cu1[qq] = run1; }
          *(f32x2*)(SEG + sq * 64 + c0) = (f32x2){run0, run1};
          unsigned rv2[4], kd2[4], kk2[4], vv2[4], bb2[4];
          const int stp = d ? -128 : 128, mt0 = moff(d ? 63 - 4 * sq : 4 * sq, c0), mt2 = moff(d ? 61 - 4 * sq : 4 * sq + 2, c0);
#pragma unroll
          for (int qq = 0; qq < 4; ++qq) { const int mo = ((qq & 2) ? mt2 : mt0) + (qq & 1) * stp;
              rv2[qq] = *(const unsigned*)(SL(8) + mo); kd2[qq] = *(const unsigned*)(SL(9) + mo); kk2[qq] = *(const unsigned*)(SL(10) + mo);
              vv2[qq] = *(const unsigned*)(SL(11) + mo); bb2[qq] = *(const unsigned*)(SL(2) + mo); }
          __syncthreads();
          float off0 = 0.f, off1 = 0.f, tot0 = 0.f, tot1 = 0.f;
#pragma unroll
          for (int s2 = 0; s2 < 16; ++s2) { const f32x2 sv = *(const f32x2*)(SEG + s2 * 64 + c0); tot0 += sv[0]; tot1 += sv[1]; off0 += (s2 < sq) ? sv[0] : 0.f; off1 += (s2 < sq) ? sv[1] : 0.f; }
          u32x2 tat0, tat1, tbh0, tbh1, tkh0, tkh1;
          const float gl0 = __expf(tot0), gl1 = __expf(tot1);
          float pe0 = __expf(off0), pe1 = __expf(off1);
#pragma unroll
          for (int qp = 0; qp < 2; ++qp) { float a0[2], a1[2], b0[2], b1[2], k0[2], k1[2];
#pragma unroll
            for (int q2 = 0; q2 < 2; ++q2) { const int qq = 2 * qp + q2; const int mo = moff(4 * sq + 2 * qp, c0) + q2 * 128;
              const float cm0 = off0 + cu0[qq], cm1 = off1 + cu1[qq];
              const float e0 = __expf(cm0), ei0 = __builtin_amdgcn_rcpf(e0), ep0 = pe0, eh0 = gl0 * ei0;
              const float e1 = __expf(cm1), ei1 = __builtin_amdgcn_rcpf(e1), ep1 = pe1, eh1 = gl1 * ei1;
              pe0 = e0; pe1 = e1;
              const float kk0 = bf2f(kk2[qq] & 0xffffu), kk1 = bf2f(kk2[qq] >> 16), bb0 = bf2f(bb2[qq] & 0xffffu), bb1 = bf2f(bb2[qq] >> 16);
              const float kd0 = bf2f(kd2[qq] & 0xffffu), kd1 = bf2f(kd2[qq] >> 16), r0 = bf2f(rv2[qq] & 0xffffu), r1 = bf2f(rv2[qq] >> 16);
              a0[q2] = -kk0 * ep0; a1[q2] = -kk1 * ep1; b0[q2] = bb0 * eh0; b1[q2] = bb1 * eh1; k0[q2] = kd0 * eh0; k1[q2] = kd1 * eh1;
              *(unsigned*)(SL(0) + mo) = cvt_pk(a0[q2], a1[q2]);
              *(unsigned*)(SL(2) + mo) = cvt_pk(bb0 * ei0, bb1 * ei1);
              *(unsigned*)(SL(3) + mo) = cvt_pk(kd0 * ei0, kd1 * ei1);
              *(unsigned*)(SL(4) + mo) = cvt_pk(r0 * e0, r1 * e1); }
            const unsigned pa0 = cvt_pk(a0[0], a0[1]), pa1 = cvt_pk(a1[0], a1[1]), pb0 = cvt_pk(b0[0], b0[1]), pb1 = cvt_pk(b1[0], b1[1]), pk0 = cvt_pk(k0[0], k0[1]), pk1 = cvt_pk(k1[0], k1[1]);
            if (qp == 0) { tat0.x = pa0; tat1.x = pa1; tbh0.x = pb0; tbh1.x = pb1; tkh0.x = pk0; tkh1.x = pk1; } else { tat0.y = pa0; tat1.y = pa1; tbh0.y = pb0; tbh1.y = pb1; tkh0.y = pk0; tkh1.y = pk1; } }
          { const int m0 = moff(c0, 4 * sq), m1 = moff(c0 + 1, 4 * sq);
            *(u32x2*)(SL(1) + m0) = tat0; *(u32x2*)(SL(1) + m1) = tat1;
            *(u32x2*)(SL(5) + m0) = tbh0; *(u32x2*)(SL(5) + m1) = tbh1;
            *(u32x2*)(SL(6) + m0) = tkh0; *(u32x2*)(SL(6) + m1) = tkh1;
            *(u32x2*)(SL(7) + m0) = (u32x2){(vv2[0] & 0xffffu) | (vv2[1] << 16), (vv2[2] & 0xffffu) | (vv2[3] << 16)};
            *(u32x2*)(SL(7) + m1) = (u32x2){(vv2[0] >> 16) | (vv2[1] & 0xffff0000u), (vv2[2] >> 16) | (vv2[3] & 0xffff0000u)}; }
          if (sq == 0) { GL[c0] = gl0; GL[c0 + 1] = gl1; } }
        __syncthreads();
        const f32x4 zero = {0.f, 0.f, 0.f, 0.f};
        int rq = r, gq = g, lq = lane; asm volatile("" : "+v"(rq), "+v"(gq), "+v"(lq));
        const int x = 16 * tx + rq;
#define FRX(slot, ks) (*(const bf16x8*)(SL(slot) + moff(16 * tx + rq, 32 * (ks) + 8 * gq)))
#define FRY(slot, tyi, ks) (*(const bf16x8*)(SL(slot) + moff(16 * (ty0 + (tyi)) + rq, 32 * (ks) + 8 * gq)))
#define MF(a, yf, xf) a = __builtin_amdgcn_mfma_f32_16x16x32_bf16(yf, xf, a, 0, 0, 0)
#define LDX(v, slot) bf16x8 v[2]; v[0] = FRX(slot, 0); v[1] = FRX(slot, 1)
#define LDY(v, slot) bf16x8 v[2][2]; v[0][0] = FRY(slot, 0, 0); v[0][1] = FRY(slot, 0, 1); v[1][0] = FRY(slot, 1, 0); v[1][1] = FRY(slot, 1, 1)
#define MM2(acc, yv, xv) do { MF(acc[0], yv[0][0], xv[0]); MF(acc[1], yv[1][0], xv[0]); MF(acc[0], yv[0][1], xv[1]); MF(acc[1], yv[1][1], xv[1]); } while (0)
#define YOF(tyi) (16 * (ty0 + (tyi)) + 4 * gq)
        { LDX(x0, 0); LDX(x3, 3); LDX(x4, 4); LDY(y2, 2); LDY(y0, 0); LDY(y3, 3);
          __builtin_amdgcn_sched_barrier(0);
          f32x4 an[2] = {zero, zero}, ak[2] = {zero, zero}, ab[2] = {zero, zero}, ar[2] = {zero, zero};
          MM2(an, y2, x0); MM2(ak, y0, x3); MM2(ab, y2, x4); MM2(ar, y3, x4);
#pragma unroll
          for (int tyi = 0; tyi < 2; ++tyi) { const int y = YOF(tyi); f32x4 tt;
#pragma unroll
            for (int j = 0; j < 4; ++j) { an[tyi][j] = (x > y + j) ? an[tyi][j] : 0.f; tt[j] = an[tyi][j] + ((x == y + j) ? 1.0f : 0.f);
                ak[tyi][j] = (x < y + j) ? ak[tyi][j] : 0.f;
                ab[tyi][j] = (y + j <= x) ? ab[tyi][j] : 0.f; ar[tyi][j] = (y + j <= x) ? ar[tyi][j] : 0.f; }
            st_row4(SL(8), x, y, an[tyi]); st_col4(SL(9), x, y, an[tyi]); st_row4(SL(13), x, y, tt);
            st_row4(SL(10), x, y, ak[tyi]); st_row4(SL(11), x, y, ab[tyi]); st_row4(SL(12), x, y, ar[tyi]); } }
        __syncthreads();
#define SQ_ONLY(xs, ys, on, om) do { LDX(xq, xs); LDY(yq, ys); __builtin_amdgcn_sched_barrier(0); f32x4 aq[2] = {zero, zero}; MM2(aq, yq, xq); \
            _Pragma("unroll") for (int tyi = 0; tyi < 2; ++tyi) { st_row4(SL(on), x, YOF(tyi), aq[tyi]); st_col4(SL(om), x, YOF(tyi), aq[tyi]); } } while (0)
#define TU_ONLY(xs, ys, os) do { LDX(xt, xs); LDY(yt, ys); f32x4 at[2]; at[0] = ld_row4(SL(xs), x, YOF(0)); at[1] = ld_row4(SL(xs), x, YOF(1)); __builtin_amdgcn_sched_barrier(0); MM2(at, yt, xt); \
            _Pragma("unroll") for (int tyi = 0; tyi < 2; ++tyi) st_row4(SL(os), x, YOF(tyi), at[tyi]); } while (0)
#define TU_SQ(txs, tys, tos, qxs, qys, qon, qom) do { LDX(xt, txs); LDY(yt, tys); LDX(xq, qxs); LDY(yq, qys); f32x4 at[2]; at[0] = ld_row4(SL(txs), x, YOF(0)); at[1] = ld_row4(SL(txs), x, YOF(1)); \
            __builtin_amdgcn_sched_barrier(0); f32x4 aq[2] = {zero, zero}; MM2(at, yt, xt); MM2(aq, yq, xq); \
            _Pragma("unroll") for (int tyi = 0; tyi < 2; ++tyi) { st_row4(SL(tos), x, YOF(tyi), at[tyi]); st_row4(SL(qon), x, YOF(tyi), aq[tyi]); st_col4(SL(qom), x, YOF(tyi), aq[tyi]); } } while (0)
        SQ_ONLY(8, 9, 0, 2); __syncthreads();
        TU_SQ(13, 2, 3, 0, 2, 8, 9); __syncthreads();
        TU_SQ(3, 9, 13, 8, 9, 0, 2); __syncthreads();
        TU_SQ(13, 2, 3, 0, 2, 8, 9); __syncthreads();
        TU_ONLY(3, 9, 13); __syncthreads();
#undef SQ_ONLY
#undef TU_ONLY
#undef TU_SQ
        { LDX(x1, 1); LDX(x10, 10); LDY(y13, 13);
          __builtin_amdgcn_sched_barrier(0);
          f32x4 ap[2] = {zero, zero}, aq[2] = {zero, zero};
          MM2(ap, y13, x1); MM2(aq, y13, x10);
#pragma unroll
          for (int tyi = 0; tyi < 2; ++tyi) { st_row4(SL(0), x, YOF(tyi), ap[tyi]); st_row4(SL(2), x, YOF(tyi), aq[tyi]); } }
        __syncthreads();
        { LDX(x11, 11); LDX(x5, 5); LDY(y0, 0); LDY(y2, 2);
          f32x4 agy[2], ags[2], awy[2], aws[2];
#pragma unroll
          for (int tyi = 0; tyi < 2; ++tyi) { const int y = YOF(tyi);
            agy[tyi] = ld_row4(SL(4), x, y); awy[tyi] = ld_row4(SL(12), x, y); aws[tyi] = ld_row4(SL(6), x, y);
#pragma unroll
            for (int j = 0; j < 4; ++j) ags[tyi][j] = (x == y + j) ? GL[x] : 0.f; }
          __builtin_amdgcn_sched_barrier(0);
          MM2(agy, y0, x11);
          MM2(ags, y0, x5);
          MM2(awy, y2, x11);
          MM2(aws, y2, x5);
#pragma unroll
          for (int tyi = 0; tyi < 2; ++tyi) { const int ty = ty0 + tyi, y = YOF(tyi);
            st_row4(SL(3), x, y, awy[tyi]); st_row4(SL(1), x, y, aws[tyi]); }
          { u32x4 w; w.x = cvt_pk(agy[0][0], agy[0][1]); w.y = cvt_pk(agy[0][2], agy[0][3]); w.z = cvt_pk(agy[1][0], agy[1][1]); w.w = cvt_pk(agy[1][2], agy[1][3]);
            *(u32x4*)(gyout + ((size_t)x * 64 + 32 * (ty0 >> 1) + 8 * gq) * 2) = w; }
          { u32x4 w; w.x = cvt_pk(ags[0][0], ags[0][1]); w.y = cvt_pk(ags[0][2], ags[0][3]); w.z = cvt_pk(ags[1][0], ags[1][1]); w.w = cvt_pk(ags[1][2], ags[1][3]);
            *(u32x4*)(gout + ((size_t)((tx * 2 + (ty0 >> 1)) * 64 + lq) * 8) * 2) = w; } }
        __syncthreads();
        { if (d + 1 < dend) SA_DMA_LORA(h, d + 1); else { int tn, dn0, dn1; SA_UNIT(q + nblk, tn, dn0, dn1); if (tn >= 0) SA_DMA_LORA((tbeg + tn) / 260, dn0); } }
        { LDX(x3, 3); LDX(x7, 7); LDY(y7, 7); LDY(y8, 1);
          __builtin_amdgcn_sched_barrier(0);
          f32x4 ayl[2] = {zero, zero}, ahs[2] = {zero, zero};
          MM2(ayl, y7, x3); MM2(ahs, y8, x7);
#pragma unroll
          for (int tyi = 0; tyi < 2; ++tyi) { const int ty = ty0 + tyi, y = YOF(tyi);
            const size_t hoff = (size_t)((tx * 4 + ty) * 64 + lq) * 8;
            { u32x2 w; w.x = cvt_pk(ahs[tyi][0], ahs[tyi][1]); w.y = cvt_pk(ahs[tyi][2], ahs[tyi][3]); *(u32x2*)(gout + 8192 + hoff) = w; } }
          { u32x4 w; w.x = cvt_pk(ayl[0][0], ayl[0][1]); w.y = cvt_pk(ayl[0][2], ayl[0][3]); w.z = cvt_pk(ayl[1][0], ayl[1][1]); w.w = cvt_pk(ayl[1][2], ayl[1][3]);
            *(u32x4*)(gyout + 8192 + ((size_t)x * 64 + 16 * gq + 4 * ty0) * 2) = w; } }
#undef FRX
#undef FRY
#undef MF
#undef LDX
#undef LDY
#undef MM2
#undef YOF
      }
    }
    __syncthreads();
}
__device__ __forceinline__ void ph_chain(const Params& P0, int b, int task, LAS unsigned char* lds) {
    const Params P = launder(P0);
    const int tid = opaque_tid(), lane = tid & 63, wid = __builtin_amdgcn_readfirstlane(tid >> 6), g = lane >> 4, v = lane & 15;
    const int hd = task >> 2, vb = task & 3;
    const unsigned char* base = P.ws + ((b == 1 && hd < 4) ? OFF_GH2 : OFF_GH) + (size_t)hd * 260 * 16384;
    bf16_t* Sg = (bf16_t*)(P.ws + OFF_XN) + ((size_t)(b * 16 + hd) * 260) * 4096 + (size_t)vb * 1024 + (size_t)lane * 8;
    constexpr int RS = 10240, NSLOT = 12, DEPTH = 8, FLG = NSLOT * RS;
    volatile LAS unsigned* fl = (volatile LAS unsigned*)(lds + FLG);
#define CH_ISSUE(n_) do { const unsigned char* cb_ = base + (size_t)(n_) * 16384; const int sl_ = (n_) % NSLOT; \
        _Pragma("unroll") for (int i_ = 0; i_ < 2; ++i_) { const int pc_ = 2 * (wid - 1) + i_; \
            const unsigned char* src_ = (pc_ < 8) ? cb_ + pc_ * 1024 : cb_ + 8192 + vb * 2048 + (pc_ - 8) * 1024; \
            __builtin_amdgcn_global_load_lds((const unsigned*)(src_ + lane * 16), (LAS unsigned*)(lds + sl_ * RS + pc_ * 1024), 16, 0, 0); } } while (0)
    const bool loader = (wid >= 1 && wid <= 5);
    if (tid < 8) fl[tid] = 0u;
    __builtin_amdgcn_s_barrier();
    if (loader) {
#pragma unroll 1
        for (int n = 0; n < 260; ++n) {
            if (n >= NSLOT) { unsigned spin = 0u; while (fl[0] + NSLOT <= (unsigned)n) { __builtin_amdgcn_s_sleep(1); if (++spin > (1u << 24)) break; } }
            asm volatile("" ::: "memory");
            CH_ISSUE(n);
            if (n >= DEPTH) { asm volatile("s_waitcnt vmcnt(16)" ::: "memory"); if (lane == 0) fl[wid] = (unsigned)(n - DEPTH + 1); }
        }
        asm volatile("s_waitcnt vmcnt(0)" ::: "memory");
        if (lane == 0) fl[wid] = 260u;
    } else if (wid == 0) {
        bf16x8 Sf[2]; Sf[0] = (bf16x8){0, 0, 0, 0, 0, 0, 0, 0}; Sf[1] = Sf[0];
        unsigned avail = 0u;
#pragma unroll 1
        for (int n = 0; n < 260; ++n) {
            if (avail <= (unsigned)n) { unsigned spin = 0u;
                for (;;) { avail = min(min(min(fl[1], fl[2]), min(fl[3], fl[4])), fl[5]); if (avail > (unsigned)n) break; __builtin_amdgcn_s_sleep(1); if (++spin > (1u << 24)) break; } }
            asm volatile("" ::: "memory");
            const LAS unsigned char* sl = lds + (n % NSLOT) * RS;
            bf16x8 gs[4][2]; u32x2 hs[4];
#pragma unroll
            for (int t = 0; t < 4; ++t) {
#pragma unroll
                for (int s2 = 0; s2 < 2; ++s2) gs[t][s2] = *(const LAS bf16x8*)(sl + ((t * 2 + s2) * 64 + lane) * 16);
                hs[t] = *(const LAS u32x2*)(sl + 8192 + (t * 64 + lane) * 8); }
            __builtin_amdgcn_sched_barrier(0);
            { const u32x4 w0 = __builtin_bit_cast(u32x4, Sf[0]), w1 = __builtin_bit_cast(u32x4, Sf[1]); bf16_t* sp = Sg + (size_t)n * 4096;
              *(u32x4*)(sp) = w0; *(u32x4*)(sp + 512) = w1; }
            f32x4 ns[4];
#pragma unroll
            for (int t = 0; t < 4; ++t) ns[t] = (f32x4){bf2f(hs[t].x & 0xffffu), bf2f(hs[t].x >> 16), bf2f(hs[t].y & 0xffffu), bf2f(hs[t].y >> 16)};
#pragma unroll
            for (int s2 = 0; s2 < 2; ++s2)
#pragma unroll
                for (int t = 0; t < 4; ++t) ns[t] = __builtin_amdgcn_mfma_f32_16x16x32_bf16(gs[t][s2], Sf[s2], ns[t], 0, 0, 0);
            { u32x4 w0, w1;
              w0.x = cvt_pk(ns[0][0], ns[0][1]); w0.y = cvt_pk(ns[0][2], ns[0][3]); w0.z = cvt_pk(ns[1][0], ns[1][1]); w0.w = cvt_pk(ns[1][2], ns[1][3]);
              w1.x = cvt_pk(ns[2][0], ns[2][1]); w1.y = cvt_pk(ns[2][2], ns[2][3]); w1.z = cvt_pk(ns[3][0], ns[3][1]); w1.w = cvt_pk(ns[3][2], ns[3][3]);
              Sf[0] = __builtin_bit_cast(bf16x8, w0); Sf[1] = __builtin_bit_cast(bf16x8, w1); }
            asm volatile("s_waitcnt lgkmcnt(0)" ::: "memory");
            if (lane == 0) fl[0] = (unsigned)(n + 1);
        }
    }
    __builtin_amdgcn_s_barrier();
    asm volatile("s_waitcnt vmcnt(0)" ::: "memory");
#undef CH_ISSUE
}
__device__ __forceinline__ void ph_pool_task(const Params& P0, int task, unsigned char* smem) {
    const Params P = launder(P0);
    const int tid = opaque_tid();
    const bf16_t* p = (const bf16_t*)(P.ws + OFF_P); bf16_t* mix = (bf16_t*)(P.ws + OFF_MIX);
    if (task < 512) {
        const int b = task >> 8, rr = task & 255, x = tid >> 3, cq = tid & 7;
        float* vs = (float*)smem;
#pragma unroll
        for (int gi = 0; gi < 4; ++gi) { const int half = 1 << gi, c = gi * 64 + cq * 8; const int rlo = max(rr - half, 0), rhi = min(rr + half, 256);
            float a[8] = {0.f, 0.f, 0.f, 0.f, 0.f, 0.f, 0.f, 0.f};
            bf16x8 xr[16];
#pragma unroll
            for (int k = 0; k < 2 * half; ++k) { const int r2 = min(max(rr - half + k, 0), 255); xr[k] = *(const bf16x8*)(p + (size_t)(b * T + r2 * 64 + x) * INC + 1792 + c); }
#pragma unroll
            for (int k = 0; k < 2 * half; ++k) { const int r2 = rr - half + k; const float m = (r2 >= rlo && r2 < rhi) ? 1.0f : 0.0f; float xf[8]; unpack8(xr[k], xf);
#pragma unroll
                for (int j = 0; j < 8; ++j) a[j] += xf[j] * m; }
            *(f32x4*)(vs + x * 260 + c) = (f32x4){a[0], a[1], a[2], a[3]}; *(f32x4*)(vs + x * 260 + c + 4) = (f32x4){a[4], a[5], a[6], a[7]}; }
        __syncthreads();
#pragma unroll
        for (int gi = 0; gi < 4; ++gi) { const int half = 1 << gi, c = gi * 64 + cq * 8; const int rlo = max(rr - half, 0), rhi = min(rr + half, 256), clo = max(x - half, 0), chi = min(x + half, 64);
            float a[8] = {0.f, 0.f, 0.f, 0.f, 0.f, 0.f, 0.f, 0.f};
            for (int x2 = clo; x2 < chi; ++x2) { const f32x4 v0 = *(const f32x4*)(vs + x2 * 260 + c), v1 = *(const f32x4*)(vs + x2 * 260 + c + 4);
#pragma unroll
                for (int j = 0; j < 4; ++j) { a[j] += v0[j]; a[4 + j] += v1[j]; } }
            const float icnt = 1.0f / (float)((rhi - rlo) * (chi - clo)); const size_t tok = (size_t)b * T + rr * 64 + x;
            float self[8]; unpack8(*(const bf16x8*)(p + tok * INC + 1792 + c), self);
#pragma unroll
            for (int j = 0; j < 8; ++j) a[j] = a[j] * icnt - self[j];
            *(bf16x8*)(mix + tok * MIXK + 512 + c) = pack8(a); }
        __syncthreads();
    } else {
        const int b = task - 512;
        for (int it = tid; it < 256 * 32; it += NT) { const int t = it >> 5, c = (it & 31) * 8, half = 1 << (c >> 6); const int lo = max(t - half, 0), hi = min(t + half, 256);
            float a[8] = {0.f, 0.f, 0.f, 0.f, 0.f, 0.f, 0.f, 0.f};
            bf16x8 xr[16];
#pragma unroll
            for (int k = 0; k < 16; ++k) { const int t2 = min(max(t - half + k, 0), 255); xr[k] = *(const bf16x8*)(p + (size_t)(LAT + b * TC + t2) * INC + 1792 + c); }
#pragma unroll
            for (int k = 0; k < 16; ++k) { const int t2 = t - half + k; const float m = (k < 2 * half && t2 >= lo && t2 < hi) ? 1.0f : 0.0f; float xf[8]; unpack8(xr[k], xf);
#pragma unroll
                for (int j = 0; j < 8; ++j) a[j] += xf[j] * m; }
            const float icnt = 1.0f / (float)(hi - lo); const size_t tok = (size_t)LAT + b * TC + t;
            float self[8]; unpack8(*(const bf16x8*)(p + tok * INC + 1792 + c), self);
#pragma unroll
            for (int j = 0; j < 8; ++j) a[j] = a[j] * icnt - self[j];
            *(bf16x8*)(mix + tok * MIXK + 512 + c) = pack8(a); }
    }
}
template <int K>
__device__ __forceinline__ void dft_task(const bf16_t* Xmat, const bf16_t* src, size_t sstride, unsigned char* smem, int mode, int b, int idx, bf16_t* Y1, bf16_t* mix) {
    constexpr int ldu = K + 8;
    const int tid = opaque_tid(), lane = tid & 63, wid = tid >> 6, r = lane & 15, g = lane >> 4;
#pragma unroll 1
    for (int it0 = tid; it0 < K * 64; it0 += 8 * NT) { u32x2 sv[8];
#pragma unroll
        for (int q = 0; q < 8; ++q) { const int it = it0 + q * NT, blk = it >> 6, l6 = it & 63, kk = (blk % (K / 16)) * 16 + (l6 & 15), c0 = ((blk / (K / 16)) * 4 + (l6 >> 4)) * 4; sv[q] = *(const u32x2*)(src + (size_t)kk * sstride + c0); }
#pragma unroll
        for (int q = 0; q < 8; ++q) { const int it = it0 + q * NT, blk = it >> 6, l6 = it & 63, kk = (blk % (K / 16)) * 16 + (l6 & 15), c0 = ((blk / (K / 16)) * 4 + (l6 >> 4)) * 4;
            *(bf16_t*)(smem + ((size_t)(c0 + 0) * ldu + kk) * 2) = (bf16_t)(sv[q].x & 0xffffu); *(bf16_t*)(smem + ((size_t)(c0 + 1) * ldu + kk) * 2) = (bf16_t)(sv[q].x >> 16);
            *(bf16_t*)(smem + ((size_t)(c0 + 2) * ldu + kk) * 2) = (bf16_t)(sv[q].y & 0xffffu); *(bf16_t*)(smem + ((size_t)(c0 + 3) * ldu + kk) * 2) = (bf16_t)(sv[q].y >> 16); } }
    bf16x8 xf[2][K / 32];
#pragma unroll
    for (int mt = 0; mt < 2; ++mt)
#pragma unroll
        for (int ks = 0; ks < K / 32; ++ks) xf[mt][ks] = *(const bf16x8*)(Xmat + (size_t)(16 * (2 * wid + mt) + r) * K + 32 * ks + 8 * g);
    __syncthreads();
    for (int ct = 0; ct < 16; ++ct) {
        f32x4 acc[2] = {{0.f, 0.f, 0.f, 0.f}, {0.f, 0.f, 0.f, 0.f}};
#pragma unroll
        for (int ks = 0; ks < K / 32; ++ks) { const bf16x8 yf = *(const bf16x8*)(smem + ((size_t)(16 * ct + r) * ldu + 32 * ks + 8 * g) * 2);
            acc[0] = __builtin_amdgcn_mfma_f32_16x16x32_bf16(yf, xf[0][ks], acc[0], 0, 0, 0); acc[1] = __builtin_amdgcn_mfma_f32_16x16x32_bf16(yf, xf[1][ks], acc[1], 0, 0, 0); }
#pragma unroll
        for (int mt = 0; mt < 2; ++mt) { const int m = 16 * (2 * wid + mt) + r, c = 16 * ct + 4 * g;
            u32x2 w; w.x = cvt_pk(acc[mt][0], acc[mt][1]); w.y = cvt_pk(acc[mt][2], acc[mt][3]);
            if (mode == 0) { const int reim = m >> 7, k1 = m & 127; *(u32x2*)(Y1 + ((size_t)(((b * 128 + k1) * 2 + reim) * 128 + idx)) * 256 + c) = w; }
            else { int reim, tok; if (mode == 1) { reim = m >> 7; tok = b * T + idx + 128 * (m & 127); } else { const int m2 = idx * 256 + m; reim = m2 >> 8; tok = LAT + b * TC + (m2 & 255); }
                *(u32x2*)(mix + (size_t)tok * MIXK + 768 + (c >> 6) * 128 + reim * 64 + (c & 63)) = w; } }
    }
    __syncthreads();
}
__device__ __forceinline__ void ph_readout(const Params& P0, int l, unsigned char* smem, int bid, int nblk, int rp) {
    const Params P = launder(P0);
    const int tid = opaque_tid(), lane = tid & 63, h = tid >> 6, r = lane & 15, g = lane >> 4;
    const bf16_t* p = (const bf16_t*)(P.ws + OFF_P); bf16_t* mix = (bf16_t*)(P.ws + OFF_MIX);
    const float* bonus = (const float*)(P.ws + OFF_BONUS);
    const float* sw = P.in[9] + (size_t)l * 3 * 1792;
    const bf16_t* gupT = (const bf16_t*)(P.ws + OFF_GUPT) + (size_t)l * 512 * 128;
    unsigned char* gwl = smem + 16384 + h * 16384;
    { bf16x8 gw[16];
#pragma unroll
      for (int q = 0; q < 16; ++q) { const int row = 4 * q + (lane >> 4), ch = lane & 15; gw[q] = *(const bf16x8*)(gupT + (size_t)(h * 64 + row) * 128 + 8 * ch); }
      __builtin_amdgcn_sched_barrier(0);
#pragma unroll
      for (int q = 0; q < 16; ++q) { const int row = 4 * q + (lane >> 4), ch = lane & 15; *(bf16x8*)(gwl + row * 256 + ((ch ^ (row & 15)) << 4)) = gw[q]; } }
    float* swl = (float*)(smem + 8704) + h * 192;
#pragma unroll
    for (int dt = 0; dt < 3; ++dt) swl[dt * 64 + lane] = sw[dt * 1792 + 1024 + h * 64 + lane];
    const int nlat2 = (LAT / 64) * 2, ntask = nlat2 + ((l == 0) ? (MT - LAT) / 64 * 2 : 0);
    const int npre = min(128 + 3 * max(nblk - 128, 0), nlat2 / 2), nrem = nlat2 - npre, per = (nrem + nblk - 1) / nblk;
    const int nit = rp ? per + 1 : 3;
    for (int it = 0; it < nit; ++it) {
        int tk;
        if (rp == 0) { if (bid < 128) { if (it >= 2) continue; tk = (bid - 64) * 2 + it; } else tk = 128 + (bid - 128) * 3 + it;
            if (tk >= npre) continue; }
        else if (it < per) { const int rr = bid * per + it; if (rr >= nrem) continue; tk = npre + rr; }
        else { tk = nlat2 + bid; if (tk >= ntask) continue; }
        const int tile = tk >> 1, tx2 = tk & 1, tok0 = tile * 64;
        int lo, hi; if (tok0 < LAT) { lo = (tok0 / T) * T; hi = lo + T; } else { lo = LAT + ((tok0 - LAT) / TC) * TC; hi = lo + TC; }
        int bb, jj; if (tok0 < LAT) { bb = tok0 / T; jj = 4 + (tok0 - bb * T) / 64; } else { bb = (tok0 - LAT) / TC; jj = ((tok0 - LAT) % TC) / 64; }
        const int n0 = jj, n1 = (jj < 4) ? 3 - jj : 263 - jj;
        const bf16_t* gy0 = (const bf16_t*)(P.ws + OFF_GY + (size_t)(((bb * 8 + h) * 2 + 0) * 260 + n0) * 16384);
        const bf16_t* gy1 = (const bf16_t*)(P.ws + OFF_GY + (size_t)(((bb * 8 + h) * 2 + 1) * 260 + n1) * 16384);
        const bf16_t* st0 = (const bf16_t*)(P.ws + OFF_XN) + ((size_t)((bb * 8 + h) * 2 + 0) * 260 + n0) * 4096;
        const bf16_t* st1 = (const bf16_t*)(P.ws + OFF_XN) + ((size_t)((bb * 8 + h) * 2 + 1) * 260 + n1) * 4096;
        const int tb = 32 * tx2 + r;
        const int tl = tid >> 5, c4 = (tid & 31) * 4;
        f32x4 ug[2];
#pragma unroll
        for (int u = 0; u < 2; ++u) ug[u] = conv4(p, sw, tok0 + 32 * tx2 + 16 * u + tl, lo, hi, 1664 + c4);
        bf16x8 x0[2][2], x1[2][2], s0[2][4], s1v[2][4];
#pragma unroll
        for (int u = 0; u < 2; ++u)
#pragma unroll
            for (int ks = 0; ks < 2; ++ks) { x0[u][ks] = *(const bf16x8*)(gy0 + (tb + 16 * u) * 64 + 32 * ks + 8 * g); x1[u][ks] = *(const bf16x8*)(gy1 + (63 - tb - 16 * u) * 64 + 32 * ks + 8 * g); }
#pragma unroll
        for (int ks = 0; ks < 2; ++ks)
#pragma unroll
            for (int cy = 0; cy < 4; ++cy) { s0[ks][cy] = *(const bf16x8*)(st0 + cy * 1024 + ks * 512 + lane * 8); s1v[ks][cy] = *(const bf16x8*)(st1 + cy * 1024 + ks * 512 + lane * 8); }
#pragma unroll
        for (int u = 0; u < 2; ++u) { u32x2 w; w.x = cvt_pk(sigmoidf_(ug[u][0]), sigmoidf_(ug[u][1])); w.y = cvt_pk(sigmoidf_(ug[u][2]), sigmoidf_(ug[u][3]));
          *(u32x2*)(smem + ((size_t)(tl + 16 * u) * 136 + c4) * 2) = w; }
        __syncthreads();
        f32x4 ys[2][4];
#pragma unroll
        for (int u = 0; u < 2; ++u)
#pragma unroll
            for (int cy = 0; cy < 4; ++cy) ys[u][cy] = (f32x4){0.f, 0.f, 0.f, 0.f};
#pragma unroll
        for (int ks = 0; ks < 2; ++ks)
#pragma unroll
            for (int cy = 0; cy < 4; ++cy)
#pragma unroll
                for (int u = 0; u < 2; ++u) { ys[u][cy] = __builtin_amdgcn_mfma_f32_16x16x32_bf16(s0[ks][cy], x0[u][ks], ys[u][cy], 0, 0, 0); ys[u][cy] = __builtin_amdgcn_mfma_f32_16x16x32_bf16(s1v[ks][cy], x1[u][ks], ys[u][cy], 0, 0, 0); }
        __builtin_amdgcn_sched_barrier(0);
#pragma unroll 1
        for (int u = 0; u < 2; ++u) {
            const int t = tb + 16 * u, tok = tok0 + t;
            u32x2 yl0[4], yl1[4]; f32x4 vv[4];
            { const u32x4 a0 = *(const u32x4*)(gy0 + 4096 + t * 64 + 16 * g), a1 = *(const u32x4*)(gy0 + 4096 + t * 64 + 16 * g + 8), b0 = *(const u32x4*)(gy1 + 4096 + (63 - t) * 64 + 16 * g), b1 = *(const u32x4*)(gy1 + 4096 + (63 - t) * 64 + 16 * g + 8);
              yl0[0] = (u32x2){a0.x, a0.y}; yl0[1] = (u32x2){a0.z, a0.w}; yl0[2] = (u32x2){a1.x, a1.y}; yl0[3] = (u32x2){a1.z, a1.w};
              yl1[0] = (u32x2){b0.x, b0.y}; yl1[1] = (u32x2){b0.z, b0.w}; yl1[2] = (u32x2){b1.x, b1.y}; yl1[3] = (u32x2){b1.z, b1.w}; }
#pragma unroll
            for (int cy = 0; cy < 4; ++cy) vv[cy] = conv4l(p, swl + 16 * cy + 4 * g, tok, lo, hi, 1024 + h * 64 + 16 * cy + 4 * g);
            const float bon = bonus[(size_t)tok * 8 + h] + bonus[((size_t)MT + tok) * 8 + h];
            f32x4 gt[4];
            float s1 = 0.f;
#pragma unroll
            for (int hf = 0; hf < 2; ++hf) {
                bf16x8 gfr[2][4];
#pragma unroll
                for (int c2 = 0; c2 < 2; ++c2)
#pragma unroll
                    for (int ks = 0; ks < 4; ++ks) { const int row = 16 * (2 * hf + c2) + r; gfr[c2][ks] = *(const bf16x8*)(gwl + row * 256 + (((4 * ks + g) ^ (row & 15)) << 4)); }
#pragma unroll
                for (int c2 = 0; c2 < 2; ++c2) { const int cy = 2 * hf + c2; f32x4 a = {0.f, 0.f, 0.f, 0.f};
#pragma unroll
                    for (int ks = 0; ks < 4; ++ks) { const bf16x8 xfr = *(const bf16x8*)(smem + ((size_t)(16 * u + r) * 136 + 32 * ks + 8 * g) * 2);
                        a = __builtin_amdgcn_mfma_f32_16x16x32_bf16(gfr[c2][ks], xfr, a, 0, 0, 0); }
                    gt[cy] = a; }
                __builtin_amdgcn_sched_barrier(0); }
#pragma unroll
            for (int cy = 0; cy < 4; ++cy) {
                ys[0][cy] = ys[0][cy] + (f32x4){bf2f(yl0[cy].x & 0xffffu) + bf2f(yl1[cy].x & 0xffffu), bf2f(yl0[cy].x >> 16) + bf2f(yl1[cy].x >> 16), bf2f(yl0[cy].y & 0xffffu) + bf2f(yl1[cy].y & 0xffffu), bf2f(yl0[cy].y >> 16) + bf2f(yl1[cy].y >> 16)};
                s1 += (ys[0][cy][0] + ys[0][cy][1]) + (ys[0][cy][2] + ys[0][cy][3]); }
            s1 += sx<16>(s1, lane); s1 += sx<32>(s1, lane);
            const float mu = s1 * (1.0f / 64.0f); float s2 = 0.f;
#pragma unroll
            for (int cy = 0; cy < 4; ++cy)
#pragma unroll
                for (int j = 0; j < 4; ++j) { const float dd = ys[0][cy][j] - mu; s2 += dd * dd; }
            s2 += sx<16>(s2, lane); s2 += sx<32>(s2, lane);
            const float rstd = rsqrtf(s2 * (1.0f / 64.0f) + 64e-5f);
#pragma unroll
            for (int cy = 0; cy < 4; ++cy) { const int hc = h * 64 + 16 * cy + 4 * g;
                f32x4 o;
                const f32x4 lgv = *(const f32x4*)(P.in[18] + l * 512 + hc), lbv = *(const f32x4*)(P.in[19] + l * 512 + hc);
#pragma unroll
                for (int j = 0; j < 4; ++j) o[j] = ((ys[0][cy][j] - mu) * rstd * lgv[j] + lbv[j] + bon * vv[cy][j]) * gt[cy][j];
                u32x2 w; w.x = cvt_pk(o[0], o[1]); w.y = cvt_pk(o[2], o[3]); *(u32x2*)(mix + (size_t)tok * MIXK + hc) = w; }
#pragma unroll
            for (int cy = 0; cy < 4; ++cy) ys[0][cy] = ys[1][cy];
        }
        __syncthreads();
    }
}
__device__ __forceinline__ void ph_norm2(const Params& P0, int l, unsigned char* smem, int bid, int nblk) {
    const Params P = launder(P0);
    const int tid = opaque_tid(), lane = tid & 63, gw = bid * 8 + (tid >> 6), ngw = nblk * 8;
    float* RW = (float*)smem;
    for (int i = tid; i < 16384; i += NT) RW[(i & 15) * 1024 + (i >> 4)] = P.in[24][(size_t)l * 16384 + i];
    __syncthreads();
    const float* mods = (const float*)(P.ws + OFF_MODS); const float* hctx = (const float*)(P.ws + OFF_HCTX);
    bf16_t* h2 = (bf16_t*)(P.ws + OFF_XN); float* aff = (float*)(P.ws + OFF_AFF); float* affc = (float*)(P.ws + OFF_AFFC);
    const float* gn = P.in[7] + l * D;
    const int nrows = (l == 0) ? MT : LAT;
    for (int pr = gw; pr < nrows / 2; pr += ngw) {
        const int rr = 2 * pr;
        const int s = (rr < LAT) ? rr / T : 2;
        const float* hrow = (rr < LAT) ? P.out + (size_t)rr * D : hctx + (size_t)(rr - LAT) * D;
        if (l == 0 && rr >= LAT) {
            float* hw = (float*)(P.ws + OFF_HCTX) + (size_t)(rr - LAT) * D; const float* slab = (const float*)(P.ws + OFF_SLAB); const float* g1 = mods + (size_t)2 * 6144 + 2048;
#pragma unroll
            for (int q = 0; q < 2; ++q) { f32x4 sv[4][5], hv[4], gv[4];
#pragma unroll
                for (int i = 0; i < 4; ++i) { const int c = 4 * lane + 256 * i;
#pragma unroll
                    for (int ks = 0; ks < 5; ++ks) sv[i][ks] = *(const f32x4*)(slab + ((size_t)ks * 512 + (rr - LAT + q)) * D + c);
                    hv[i] = *(const f32x4*)(hw + q * D + c); gv[i] = *(const f32x4*)(g1 + c); }
                __builtin_amdgcn_sched_barrier(0);
#pragma unroll
                for (int i = 0; i < 4; ++i) { const int c = 4 * lane + 256 * i;
                    *(f32x4*)(hw + q * D + c) = hv[i] + gv[i] * ((((sv[i][0] + sv[i][1]) + sv[i][2]) + sv[i][3]) + sv[i][4]); }
                __builtin_amdgcn_sched_barrier(0); }
            asm volatile("s_waitcnt vmcnt(0)" ::: "memory"); __builtin_amdgcn_fence(__ATOMIC_ACQUIRE, "agent"); asm volatile("s_waitcnt vmcnt(0)" ::: "memory"); }
        f32x4 v[2][4]; float ss[2] = {0.f, 0.f};
#pragma unroll
        for (int q = 0; q < 2; ++q)
#pragma unroll
            for (int i = 0; i < 4; ++i) { v[q][i] = *(const f32x4*)(hrow + q * D + 4 * lane + 256 * i); ss[q] += (v[q][i][0] * v[q][i][0] + v[q][i][1] * v[q][i][1]) + (v[q][i][2] * v[q][i][2] + v[q][i][3] * v[q][i][3]); }
        float rs[2];
#pragma unroll
        for (int q = 0; q < 2; ++q) rs[q] = rsqrtf(wave_sum(ss[q], lane) * (1.0f / D) + 1e-6f);
        const float* sh = mods + (size_t)(l * 3 + s) * 6144 + 3072, *sc = sh + 1024;
        float lg[2][16];
#pragma unroll
        for (int q = 0; q < 2; ++q)
#pragma unroll
            for (int e = 0; e < 16; ++e) lg[q][e] = 0.f;
        f32x4 nv[2], ngn, nsc, nsh;
        { const int c0 = 4 * lane; nv[0] = *(const f32x4*)(hrow + c0); nv[1] = *(const f32x4*)(hrow + D + c0); ngn = *(const f32x4*)(gn + c0); nsc = *(const f32x4*)(sc + c0); nsh = *(const f32x4*)(sh + c0); }
#pragma unroll 1
        for (int i = 0; i < 4; ++i) { const int c = 4 * lane + 256 * i;
            const f32x4 gm = ngn * (nsc + 1.0f), shv = nsh; const f32x4 cv0 = nv[0], cv1 = nv[1];
            if (i < 3) { const int c1 = c + 256; nv[0] = *(const f32x4*)(hrow + c1); nv[1] = *(const f32x4*)(hrow + D + c1); ngn = *(const f32x4*)(gn + c1); nsc = *(const f32x4*)(sc + c1); nsh = *(const f32x4*)(sh + c1); }
            f32x4 y[2];
#pragma unroll
            for (int q = 0; q < 2; ++q) { y[q] = (q == 0 ? cv0 : cv1) * rs[q] * gm + shv;
                u32x2 w; w.x = cvt_pk(y[q][0], y[q][1]); w.y = cvt_pk(y[q][2], y[q][3]); *(u32x2*)(h2 + (size_t)(rr + q) * D + c) = w; }
#pragma unroll
            for (int e = 0; e < 16; ++e) { const f32x4 wv = *(const f32x4*)(RW + e * 1024 + c);
#pragma unroll
                for (int q = 0; q < 2; ++q) lg[q][e] += (y[q][0] * wv[0] + y[q][1] * wv[1]) + (y[q][2] * wv[2] + y[q][3] * wv[3]); }
            }
#pragma unroll
        for (int q = 0; q < 2; ++q) {
        float a8[8], a4[4], a2[2], a1;
        { const bool up = (lane & 32) != 0;
#pragma unroll
          for (int k = 0; k < 8; ++k) { const float keep = up ? lg[q][8 + k] : lg[q][k], send = up ? lg[q][k] : lg[q][8 + k]; a8[k] = keep + sx<32>(send, lane); } }
        { const bool up = (lane & 16) != 0;
#pragma unroll
          for (int k = 0; k < 4; ++k) { const float keep = up ? a8[4 + k] : a8[k], send = up ? a8[k] : a8[4 + k]; a4[k] = keep + sx<16>(send, lane); } }
        { const bool up = (lane & 8) != 0;
#pragma unroll
          for (int k = 0; k < 2; ++k) { const float keep = up ? a4[2 + k] : a4[k], send = up ? a4[k] : a4[2 + k]; a2[k] = keep + sx<8>(send, lane); } }
        { const bool up = (lane & 4) != 0; const float keep = up ? a2[1] : a2[0], send = up ? a2[0] : a2[1]; a1 = keep + sx<4>(send, lane); }
        a1 += sx<1>(a1, lane); a1 += sx<2>(a1, lane);
        float mx = a1;
        mx = fmaxf(mx, sx<4>(mx, lane)); mx = fmaxf(mx, sx<8>(mx, lane)); mx = fmaxf(mx, sx<16>(mx, lane)); mx = fmaxf(mx, sx<32>(mx, lane));
        const float ex = __expf(a1 - mx); float sm = ex;
        sm += sx<4>(sm, lane); sm += sx<8>(sm, lane); sm += sx<16>(sm, lane); sm += sx<32>(sm, lane);
        const int r1 = rr + q;
        if ((lane & 3) == 0) { const int e = ((lane >> 5) & 1) * 8 + ((lane >> 4) & 1) * 4 + ((lane >> 3) & 1) * 2 + ((lane >> 2) & 1); const float a = ex / sm;
            if (r1 < LAT) aff[(size_t)((r1 / T) * 16 + e) * T + (r1 % T)] = a; else affc[(size_t)(((r1 - LAT) / TC) * 16 + e) * TC + ((r1 - LAT) % TC)] = a; }
        }
    }
    __syncthreads();
}
__device__ __forceinline__ void ph_topk_task(const Params& P0, int pid, unsigned char* smem) {
    const Params P = launder(P0);
    const int tid = opaque_tid(), lane = tid & 63, wid = tid >> 6;
    int* idx = (int*)(P.ws + OFF_IDX); float* gate = (float*)(P.ws + OFF_GATE); int* inv = (int*)(P.ws + OFF_INV);
    unsigned* hist = (unsigned*)smem;
    unsigned* sh = (unsigned*)(smem + 1024);
    if (pid < 32) {
        const int b = pid >> 4, e = pid & 15;
        const float* a = (const float*)(P.ws + OFF_AFF) + (size_t)pid * T + tid * 32;
        unsigned key[32];
#pragma unroll
        for (int i = 0; i < 8; ++i) { const f32x4 v = *(const f32x4*)(a + 4 * i); key[4 * i] = __float_as_uint(v[0]); key[4 * i + 1] = __float_as_uint(v[1]); key[4 * i + 2] = __float_as_uint(v[2]); key[4 * i + 3] = __float_as_uint(v[3]); }
        unsigned prefix = 0u, need = CAP;
        for (int pass = 3; pass >= 0; --pass) {
            const int shf = pass * 8;
            if (tid < 256) hist[tid] = 0u;
            __syncthreads();
            const unsigned himask = (pass == 3) ? 0u : (0xffffffffu << (shf + 8));
            if (pass == 3) {
                const unsigned b0 = key[0] >> 24; unsigned c0 = 0u;
#pragma unroll
                for (int i = 0; i < 32; ++i) c0 += ((key[i] >> 24) == b0) ? 1u : 0u;
                atomicAdd(&hist[b0], c0);
                if (c0 != 32u) {
#pragma unroll
                    for (int i = 0; i < 32; ++i) if ((key[i] >> 24) != b0) atomicAdd(&hist[key[i] >> 24], 1u); }
            } else {
#pragma unroll
                for (int i = 0; i < 32; ++i) if ((key[i] & himask) == (prefix & himask)) atomicAdd(&hist[(key[i] >> shf) & 255u], 1u); }
            __syncthreads();
            unsigned hb = 0u, suf = 0u;
            if (tid < 256) { hb = hist[tid]; suf = hb;
#pragma unroll
                for (int o = 1; o < 64; o <<= 1) { const unsigned t2 = (unsigned)__builtin_amdgcn_ds_bpermute(((lane + o) & 63) << 2, (int)suf); if (lane + o < 64) suf += t2; }
                if (lane == 0) sh[4 + wid] = suf; }
            __syncthreads();
            if (tid < 256) { for (int w2 = wid + 1; w2 < 4; ++w2) suf += sh[4 + w2];
                if (suf >= need && suf - hb < need) { sh[0] = prefix | ((unsigned)tid << shf); sh[1] = need - (suf - hb); } }
            __syncthreads();
            prefix = sh[0]; need = sh[1];
            __syncthreads();
        }
        unsigned neq = 0u, ngt = 0u;
#pragma unroll
        for (int i = 0; i < 32; ++i) { neq += (key[i] == prefix); ngt += (key[i] > prefix); }
        unsigned eq_incl = neq;
#pragma unroll
        for (int o = 1; o < 64; o <<= 1) { const unsigned t2 = (unsigned)__builtin_amdgcn_ds_bpermute(((lane - o) & 63) << 2, (int)eq_incl); if (lane >= o) eq_incl += t2; }
        if (lane == 63) sh[8 + wid] = eq_incl;
        __syncthreads();
        unsigned eq_off = eq_incl - neq;
        for (int w2 = 0; w2 < wid; ++w2) eq_off += sh[8 + w2];
        unsigned nsel = ngt, er = eq_off;
#pragma unroll
        for (int i = 0; i < 32; ++i) if (key[i] == prefix) { nsel += (er < need); ++er; }
        unsigned sel_incl = nsel;
#pragma unroll
        for (int o = 1; o < 64; o <<= 1) { const unsigned t2 = (unsigned)__builtin_amdgcn_ds_bpermute(((lane - o) & 63) << 2, (int)sel_incl); if (lane >= o) sel_incl += t2; }
        if (lane == 63) sh[16 + wid] = sel_incl;
        __syncthreads();
        unsigned slot = sel_incl - nsel;
        for (int w2 = 0; w2 < wid; ++w2) slot += sh[16 + w2];
        er = eq_off;
#pragma unroll
        for (int i = 0; i < 32; ++i) { const int t = tid * 32 + i; bool s = key[i] > prefix;
            if (key[i] == prefix) { s = (er < need); ++er; }
            const int tok = b * T + t;
            if (s) { idx[(size_t)pid * CAP + slot] = tok; gate[(size_t)pid * CAP + slot] = __uint_as_float(key[i]); inv[(size_t)tok * 16 + e] = (int)slot; ++slot; }
            else inv[(size_t)tok * 16 + e] = -1; }
        __syncthreads();
    } else {
        const int gidx = pid - 32, b = gidx >> 4, e = gidx & 15;
        float* vals = (float*)(smem + 2048);
        const float* a = (const float*)(P.ws + OFF_AFFC) + (size_t)gidx * TC;
        if (tid < 256) vals[tid] = a[tid];
        __syncthreads();
        if (tid < 256) { const float mv = vals[tid]; int rank = 0;
            for (int j = 0; j < 256; ++j) { const float o = vals[j]; rank += (o > mv) || (o == mv && j < tid); }
            const int tok = LAT + b * TC + tid;
            idx[65536 + (size_t)gidx * 256 + rank] = tok; gate[65536 + (size_t)gidx * 256 + rank] = (rank < CAPC) ? mv : 0.f;
            inv[(size_t)tok * 16 + e] = (rank < CAPC) ? rank : -1; }
        __syncthreads();
    }
}
__device__ __forceinline__ void ph_convw(const Params& P0, int l, unsigned char* smem, int t0, int t1) {
    const Params P = launder(P0);
    const int tid = opaque_tid();
    float* tile = (float*)smem;
    for (int t = t0; t < t1; ++t) { const int mat = t >> 6, rr = t & 63, tk = rr >> 2, tn4 = rr & 3, kind = mat >> 4, e = mat & 15;
        const float* src = (kind == 0 ? P.in[25] : (kind == 1 ? P.in[26] : P.in[27])) + (size_t)(l * 16 + e) * D * D;
        bf16_t* dst = (kind < 2) ? (bf16_t*)(P.ws + OFF_WGU) + (size_t)e * 2048 * D : (bf16_t*)(P.ws + OFF_WD) + (size_t)e * D * D;
        f32x4 v[8];
#pragma unroll
        for (int i = 0; i < 8; ++i) { const int eidx = tid + i * NT, kk = eidx >> 6, n4 = (eidx & 63) * 4; v[i] = *(const f32x4*)(src + (size_t)(tk * 64 + kk) * D + tn4 * 256 + n4); }
#pragma unroll
        for (int i = 0; i < 8; ++i) { const int eidx = tid + i * NT, kk = eidx >> 6, n4 = (eidx & 63) * 4; *(f32x4*)(tile + kk * 260 + n4) = v[i]; }
        __syncthreads();
        { const int n = tid >> 1, k0 = (tid & 1) * 32; const int ng = tn4 * 256 + n;
          int row = ng; if (kind == 0) row = (ng >> 7) * 256 + (ng & 127); else if (kind == 1) row = (ng >> 7) * 256 + 128 + (ng & 127);
#pragma unroll
          for (int c = 0; c < 4; ++c) { float o[8];
#pragma unroll
              for (int j = 0; j < 8; ++j) o[j] = tile[(k0 + 8 * c + j) * 260 + n];
              *(bf16x8*)(dst + (size_t)row * D + tk * 64 + k0 + 8 * c) = pack8(o); } }
        __syncthreads();
    }
}
__device__ __forceinline__ void ph_gather(const Params& P0, int l, int bid, int nblk) {
    const Params P = launder(P0);
    const int lane = opaque_tid() & 63, gw = bid * 8 + (opaque_tid() >> 6), ngw = nblk * 8;
    const int* idx = (const int*)(P.ws + OFF_IDX); const bf16_t* h2 = (const bf16_t*)(P.ws + OFF_XN); bf16_t* xe = (bf16_t*)(P.ws + OFF_XE);
    const int nrow = 65536 + ((l == 0) ? 32 * 32 : 0);
    for (int i0 = gw * 4; i0 < nrow; i0 += ngw * 4) {
        int row[4], tok[4]; u32x4 a[4], c[4];
#pragma unroll
        for (int q = 0; q < 4; ++q) { const int i = i0 + q; row[q] = (i < 65536) ? i : 65536 + ((i - 65536) >> 5) * 256 + ((i - 65536) & 31); tok[q] = idx[row[q]]; }
#pragma unroll
        for (int q = 0; q < 4; ++q) { a[q] = *(const u32x4*)(h2 + (size_t)tok[q] * D + lane * 8); c[q] = *(const u32x4*)(h2 + (size_t)tok[q] * D + 512 + lane * 8); }
#pragma unroll
        for (int q = 0; q < 4; ++q) { *(u32x4*)(xe + (size_t)row[q] * D + lane * 8) = a[q]; *(u32x4*)(xe + (size_t)row[q] * D + 512 + lane * 8) = c[q]; }
    }
}

__device__ __forceinline__ void ph_moe2_ctx(const Params& P0, int bid, int nblk) {
    const Params P = launder(P0);
    const int tid = opaque_tid(), lane = tid & 63, wid = tid >> 6, r = lane & 15, g = lane >> 4;
    const bf16_t* hid = (const bf16_t*)(P.ws + OFF_HID); const bf16_t* wd = (const bf16_t*)(P.ws + OFF_WD);
    bf16_t* ye = (bf16_t*)(P.ws + OFF_XE); const float* gate = (const float*)(P.ws + OFF_GATE);
    const int mt = wid & 3, np = wid >> 2;
    for (int item = bid; item < 256; item += nblk) {
        const int e = item >> 4, nc = item & 15;
        const int row = 65536 + ((mt >> 1) * 16 + e) * 256 + 16 * (mt & 1) + r;
        const int n0 = nc * 64 + np * 32;
        const bf16_t* ap = hid + (size_t)row * D + 8 * g;
        const bf16_t* bp = wd + ((size_t)e * D + n0 + r) * D + 8 * g;
        const float gs = gate[row];
        f32x4 acc0 = {0.f, 0.f, 0.f, 0.f}, acc1 = acc0;
#pragma unroll 8
        for (int ks = 0; ks < 32; ++ks) { const bf16x8 a = *(const bf16x8*)(ap + 32 * ks), b0 = *(const bf16x8*)(bp + 32 * ks), b1 = *(const bf16x8*)(bp + (size_t)16 * D + 32 * ks);
            acc0 = __builtin_amdgcn_mfma_f32_16x16x32_bf16(b0, a, acc0, 0, 0, 0); acc1 = __builtin_amdgcn_mfma_f32_16x16x32_bf16(b1, a, acc1, 0, 0, 0); }
        { u32x2 w; w.x = cvt_pk(acc0[0] * gs, acc0[1] * gs); w.y = cvt_pk(acc0[2] * gs, acc0[3] * gs); *(u32x2*)(ye + (size_t)row * D + n0 + 4 * g) = w; }
        { u32x2 w; w.x = cvt_pk(acc1[0] * gs, acc1[1] * gs); w.y = cvt_pk(acc1[2] * gs, acc1[3] * gs); *(u32x2*)(ye + (size_t)row * D + n0 + 16 + 4 * g) = w; }
    }
}

__global__ void __launch_bounds__(NT, 2) hybrid_fwd(Params PK) {
    extern __shared__ __attribute__((aligned(16))) unsigned char smem[];
    const int tid = opaque_tid(), G = gridDim.x, bid = blockIdx.x;
    LAS unsigned char* lds = (LAS unsigned char*)smem;
    if (tid < 64) ((volatile LAS unsigned*)(lds + LDS_MISC))[tid] = 0u;
    __syncthreads();
    (void)xcd_barrier_post((unsigned*)(PK.ws + OFF_CTL), (volatile LAS unsigned*)(lds + LDS_MISC));
    if (PROF_A >= 0 && bid == 0 && tid == 0) ((unsigned long long*)(PK.ws + OFF_CTL + 15360))[0] = __builtin_amdgcn_s_memrealtime();
#define GRID_SYNC(K_) do { size_t zb_ = 0; asm volatile("" : "+s"(zb_)); unsigned* bp_ = (unsigned*)(PK.ws + OFF_CTL + zb_); XcdBarrier bar_; bar_.bar = bp_; bar_.x = xb_xcc_id(); bar_.st = (volatile LAS unsigned*)(lds + LDS_MISC); xcd_barrier(bar_); \
        if (PROF_A >= 0) { if (bid == 0 && opaque_tid() == 0) ((unsigned long long*)(bp_ + 3840))[(K_)] = __builtin_amdgcn_s_memrealtime(); } \
        if (STOP_AFTER > 0 && (K_) >= STOP_AFTER) { if (DUMP_OFF) { const unsigned* srcw = (const unsigned*)(PK.ws + (size_t)DUMP_OFF); const int t3_ = opaque_tid(); for (size_t i = (size_t)bid * NT + t3_; i < (size_t)DUMP_WORDS; i += (size_t)G * NT) PK.out[i] = (float)(srcw[i] & 0xffffffu); } return; } } while (0)

    if (EN(0)) ph_mods(PK, smem, bid, G);
    GRID_SYNC(1);
    { const int nprep = (G > 2 * NPREP) ? NPREP : G / 2, nnorm = G - nprep;
      if (bid < nnorm) { if (EN(1)) ph_norm1(PK, 0, smem, bid, nnorm); }
      else if (EN(0)) { const int vb = bid - nnorm; ph_fold(PK, smem, vb, nprep); ph_prep_weights(PK, smem, vb, nprep); ph_tables(PK, vb, nprep); } }
    GRID_SYNC(2);

#pragma unroll 1
    for (int l = 0; l < 2; ++l) {
        const int sb = l ? 15 : 2;
        if (EN(1)) if (l > 0) { ph_norm1(PK, 1, smem, bid, G); GRID_SYNC(15); }
        if (EN(2)) { const Params P = launder(PK); pg8::SchedDense S; S.init(MT, INC, D, G, bid, P.ws + OFF_XN, P.ws + OFF_WINT + (size_t)l * INC * D * 2);
          pg8::EpiBf16Plain E{(bf16_t*)(P.ws + OFF_P), INC};
          pg8::gemm_phase<pg8::EpiBf16Plain, pg8::SchedDense>(lds, D, D, S, E); }
        GRID_SYNC(sb + 1);
#pragma unroll 1
        for (int sp = 0; sp < 3; ++sp) {
        if (sp == 1) {
        if (bid < 64) { if (EN(4)) ph_chain(PK, 0, bid, lds); if (PROF_A >= 0 && l == 0 && bid == 0 && opaque_tid() == 0) ((unsigned long long*)(PK.ws + OFF_CTL + 15360))[50] = __builtin_amdgcn_s_memrealtime(); }
        else if (EN(5)) { const Params P = launder(PK);
            const int vb = bid - 64, nvb = G - 64;
            for (int task = vb; task < 256; task += nvb) { const int b = task >> 7, t2 = task & 127;
                dft_task<128>((const bf16_t*)(P.ws + OFF_D1), (const bf16_t*)(P.ws + OFF_P) + (size_t)(b * T + t2) * INC + 2048, (size_t)128 * INC, smem, 0, b, t2, (bf16_t*)(P.ws + OFF_Y1), (bf16_t*)(P.ws + OFF_MIX)); }
            const int npool = (l == 0) ? 514 : 512;
            if (PROF_A >= 0 && l == 0 && bid == 64 && opaque_tid() == 0) ((unsigned long long*)(PK.ws + OFF_CTL + 15360))[54] = __builtin_amdgcn_s_memrealtime();
            for (int task = vb; task < npool; task += nvb) ph_pool_task(PK, task, smem);
            if (l == 0) for (int task = nvb - 1 - vb; task < 4; task += nvb) { const int b = task >> 1, half = task & 1;
                dft_task<256>((const bf16_t*)(P.ws + OFF_DCTX) + (size_t)half * 65536, (const bf16_t*)(P.ws + OFF_P) + (size_t)(LAT + b * TC) * INC + 2048, INC, smem, 2, b, half, (bf16_t*)(P.ws + OFF_Y1), (bf16_t*)(P.ws + OFF_MIX)); }
            if (PROF_A >= 0 && l == 0 && bid == 64 && opaque_tid() == 0) ((unsigned long long*)(PK.ws + OFF_CTL + 15360))[51] = __builtin_amdgcn_s_memrealtime();
        }
        }
        { int sbid = bid, snb = G, sb1 = 0, stb = 0, snt = 2080; bool run = true;
          if (sp == 1) { run = (bid >= 64); sbid = G - 1 - bid; snb = G - 64; sb1 = 1; snt = SA_EARLY; }
          else if (sp == 2) { sb1 = 1; stb = SA_EARLY; snt = 2080 - SA_EARLY; }
          if (run && EN(3)) ph_sa(PK, l, sb1, smem, sbid, snb, stb, snt); }
        GRID_SYNC(sb + 2 + sp);
        }
#pragma unroll 1
        for (int rp = 0; rp < 2; ++rp) {
        if (rp == 0) {
        if (bid < 64) { if (EN(4)) ph_chain(PK, 1, bid, lds); if (PROF_A >= 0 && l == 0 && bid == 0 && opaque_tid() == 0) ((unsigned long long*)(PK.ws + OFF_CTL + 15360))[52] = __builtin_amdgcn_s_memrealtime(); }
        else if (EN(6)) { const Params P = launder(PK);
            const int vb = bid - 64, nvb = G - 64;
            for (int task = vb; task < 256; task += nvb) { const int b = task >> 7, k1 = task & 127;
                dft_task<256>((const bf16_t*)(P.ws + OFF_E2) + (size_t)k1 * 65536, (const bf16_t*)(P.ws + OFF_Y1) + (size_t)(b * 128 + k1) * 65536, 256, smem, 1, b, k1, (bf16_t*)(P.ws + OFF_Y1), (bf16_t*)(P.ws + OFF_MIX)); }
        }
        }
        if (EN(7) && (rp == 1 || bid >= 64)) ph_readout(PK, l, smem, bid, G, rp);
        GRID_SYNC(sb + 5 + rp);
        }
        if (EN(8)) { const Params P = launder(PK); pg8::SchedDense S; S.init(LAT, D, MIXK, G, bid, P.ws + OFF_MIX, P.ws + OFF_WOT + (size_t)l * D * MIXK * 2);
          pg8::EpiResid E{P.out, (float*)(P.ws + OFF_HCTX), (const float*)(P.ws + OFF_MODS) + (size_t)l * 3 * 6144};
          pg8::gemm_phase<pg8::EpiResid, pg8::SchedDense>(lds, MIXK, MIXK, S, E); }
        if (EN(8) && l == 0) { const Params P = launder(PK);
          pg8::SchedCtxK S{bid, (const char*)(P.ws + OFF_MIX) + (size_t)LAT * MIXK * 2, (const char*)(P.ws + OFF_WOT), nullptr};
          pg8::EpiSlab E{(float*)(P.ws + OFF_SLAB)};
          pg8::gemm_phase<pg8::EpiSlab, pg8::SchedCtxK>(lds, 256, MIXK, S, E); }
        GRID_SYNC(sb + 7);
        if (EN(9)) ph_norm2(PK, l, smem, bid, G);
        GRID_SYNC(sb + 8);
        if (bid < 64) { if (EN(10)) if (bid < 32 || l == 0) ph_topk_task(PK, bid, smem); if (PROF_A >= 0 && l == 0 && bid == 0 && opaque_tid() == 0) ((unsigned long long*)(PK.ws + OFF_CTL + 15360))[55] = __builtin_amdgcn_s_memrealtime(); }
        if (EN(11)) { int t0, t1;
            if (G == 256) { if (bid < 32) { t0 = 5 * bid; t1 = t0 + 5; } else if (bid < 64) { t0 = 160 + 12 * (bid - 32); t1 = t0 + 12; }
                            else if (bid < 96) { t0 = 544 + 14 * (bid - 64); t1 = t0 + 14; } else { t0 = 992 + 13 * (bid - 96); t1 = t0 + 13; } }
            else { const int per = (3072 + G - 1) / G; t0 = bid * per; t1 = min(t0 + per, 3072); }
            ph_convw(PK, l, smem, t0, t1); if (PROF_A >= 0 && l == 0 && bid == 64 && opaque_tid() == 0) ((unsigned long long*)(PK.ws + OFF_CTL + 15360))[56] = __builtin_amdgcn_s_memrealtime(); }
        GRID_SYNC(sb + 9);
        if (EN(12)) { const Params P = launder(PK); pg8::SchedMoe1 S{bid, l == 0, (const char*)(P.ws + OFF_XN), (const char*)(P.ws + OFF_WGU), (size_t)256 * D * 2, (const int*)(P.ws + OFF_IDX)};
          pg8::EpiSwiglu E{(bf16_t*)(P.ws + OFF_HID)};
          pg8::gemm_phase<pg8::EpiSwiglu, pg8::SchedMoe1>(lds, D, D, S, E); }
        GRID_SYNC(sb + 11);
        if (EN(13)) { const Params P = launder(PK); pg8::SchedMoe2 S{bid, false, (const char*)(P.ws + OFF_HID), (const char*)(P.ws + OFF_WD), (size_t)256 * D * 2, nullptr};
          pg8::EpiScaleRow E{(bf16_t*)(P.ws + OFF_XE), (const float*)(P.ws + OFF_GATE)};
          pg8::gemm_phase<pg8::EpiScaleRow, pg8::SchedMoe2>(lds, D, D, S, E); }
        if (EN(13) && l == 0) ph_moe2_ctx(PK, bid, G);
        GRID_SYNC(sb + 12);
    }
    if (EN(1)) ph_norm1(PK, 2, smem, bid, G);
    if (PROF_A >= 0) {
        GRID_SYNC(28);
        const unsigned long long* ts = (const unsigned long long*)(PK.ws + OFF_CTL + 15360);
        const float da = PROF_BINS * log2f(fmaxf((float)(ts[PROF_A] - ts[PROF_A0]) * 0.01f, 1.0f)), db = PROF_BINS * log2f(fmaxf((float)(ts[PROF_B] - ts[PROF_B0]) * 0.01f, 1.0f));
        const float c = sqrtf(floorf(da + 0.5f));
        const int t2_ = opaque_tid();
        for (size_t i = (size_t)bid * NT + t2_; i < (size_t)LAT * D; i += (size_t)G * NT) PK.out[i] = (i & 1) ? -c : c;
        if (bid == 0 && t2_ == 0) PK.out[0] = 100.0f + 10.0f * floorf(db + 0.5f);
    }
}

extern "C" void kernel_launch(void* const* d_in, const int* in_sizes, int n_in, void* d_out, int out_size, void* d_ws, size_t ws_size, hipStream_t stream) {
    static int grid = 0;
    if (grid == 0) {
        if (n_in != 29 || out_size != LAT * D || ws_size < WS_NEED) { fprintf(stderr, "kernel_launch: unexpected shapes (n_in %d, out %d, ws %zu < %zu)\n", n_in, out_size, ws_size, (size_t)WS_NEED); grid = -1; return; }
        int dev = 0, cus = 0;
        if (hipGetDevice(&dev) != hipSuccess || hipDeviceGetAttribute(&cus, hipDeviceAttributeMultiprocessorCount, dev) != hipSuccess) { grid = -1; return; }
        if (hipFuncSetAttribute((const void*)hybrid_fwd, hipFuncAttributeMaxDynamicSharedMemorySize, LDS_BYTES) != hipSuccess) { fprintf(stderr, "kernel_launch: hipFuncSetAttribute failed\n"); grid = -1; return; }
        (void)hipGetLastError();
        grid = cus;
    }
    if (grid < 0) return;
    if (hipMemsetAsync((char*)d_ws + OFF_CTL, 0, 16384, stream) != hipSuccess) return;
    Params p{};
    for (int i = 0; i < 29; ++i) p.in[i] = (const float*)d_in[i];
    p.out = (float*)d_out; p.ws = (unsigned char*)d_ws;
    hipLaunchKernelGGL(hybrid_fwd, dim3(grid), dim3(NT), LDS_BYTES, stream, p);
}
```
